# Optimizing an MI355X kernel written in HIP

```python
import math
import jax, jax.numpy as jnp
from jax import lax
import numpy as np

D_MODEL = 1024
BATCH = 4
SEQ = 8192
DEPTH = 1

EPS = 1e-6
D_RNN = D_MODEL
N_RNN_BLOCKS = 8
RNN_BLOCK = D_RNN // N_RNN_BLOCKS
RNN_CONV = 4
RG_C = 8.0
HEAD_DIM = 64
N_HEADS = D_MODEL // (2 * HEAD_DIM)
V_HEAD_DIM = 2 * HEAD_DIM
D_QK = N_HEADS * 2 * HEAD_DIM
D_V = N_HEADS * V_HEAD_DIM
ATTN_SCALE = HEAD_DIM ** -0.5
Q_BLOCK = 128
D_FF = 3 * D_MODEL
FFN_CONV = 3
SPLITS = (D_RNN, 2 * D_RNN, 2 * D_RNN + D_QK, 2 * D_RNN + 2 * D_QK,
          2 * D_RNN + 2 * D_QK + D_V, 2 * D_RNN + 2 * D_QK + D_V + D_MODEL)
D_IN = SPLITS[-1] + D_MODEL

kernel_name = "hybrid_rglru_diffattn_convffn"


def lambda_init_for(layer_idx):
    return 0.8 - 0.6 * math.exp(-0.3 * layer_idx)


def rms_norm(x, g, eps=EPS):
    xf = x.astype(jnp.float32)
    y = xf * lax.rsqrt(jnp.mean(xf * xf, axis=-1, keepdims=True) + eps)
    return (y * g.astype(jnp.float32)).astype(x.dtype)


def causal_dwconv(x, w, b):
    k_width, c = w.shape
    y = lax.conv_general_dilated(
        x, w[:, None, :].astype(x.dtype), window_strides=(1,),
        padding=[(k_width - 1, 0)], dimension_numbers=("NWC", "WIO", "NWC"),
        feature_group_count=c)
    return y + b


def _linear_recurrence(left, right):
    a_l, b_l = left
    a_r, b_r = right
    return a_l * a_r, a_r * b_l + b_r


def rg_lru(x, wa, ba, wx, bx, lam):
    bsz, s, _ = x.shape
    xb = x.reshape(bsz, s, N_RNN_BLOCKS, RNN_BLOCK)
    r = jax.nn.sigmoid(jnp.einsum('bsni,nij->bsnj', xb, wa).reshape(bsz, s, D_RNN) + ba)
    i = jax.nn.sigmoid(jnp.einsum('bsni,nij->bsnj', xb, wx).reshape(bsz, s, D_RNN) + bx)
    log_a = (-RG_C * r.astype(jnp.float32)) * jax.nn.softplus(-lam.astype(jnp.float32))
    a = jnp.exp(log_a)
    mult = jnp.sqrt(jnp.maximum(-jnp.expm1(2.0 * log_a), 0.0))
    b = mult * (i * x).astype(jnp.float32)
    _, h = lax.associative_scan(_linear_recurrence, (a, b), axis=1)
    return h.astype(x.dtype)


def diff_attention(q, k, v, lam):
    bsz, s = q.shape[:2]
    nb = s // Q_BLOCK
    qb = q.reshape(bsz, nb, Q_BLOCK, N_HEADS, 2, HEAD_DIM).transpose(1, 0, 2, 3, 4, 5)
    starts = jnp.arange(nb, dtype=jnp.int32) * Q_BLOCK
    k_pos = jnp.arange(s, dtype=jnp.int32)
    lam32 = lam.astype(jnp.float32)

    def one_block(args):
        q_blk, start = args
        sc = jnp.einsum('bqhmd,bkhmd->bhmqk', q_blk, k).astype(jnp.float32) * ATTN_SCALE
        q_pos = start + jnp.arange(Q_BLOCK, dtype=jnp.int32)
        causal = k_pos[None, :] <= q_pos[:, None]
        p = jax.nn.softmax(jnp.where(causal, sc, -jnp.inf), axis=-1)
        attn = p[:, :, 0] - lam32 * p[:, :, 1]
        return jnp.einsum('bhqk,bkhe->bqhe', attn.astype(v.dtype), v)

    o = lax.map(one_block, (qb, starts))
    return o.transpose(1, 0, 2, 3, 4).reshape(bsz, s, N_HEADS, V_HEAD_DIM)


def setup_inputs(seed: int = 0) -> dict:
    key = jax.random.key(seed)
    ks = jax.random.split(key, 32)
    f32 = jnp.float32

    def nrm(k, shape, scale):
        return jax.random.normal(k, shape, f32) * scale

    def gain(k, shape):
        return 1.0 + 0.02 * jax.random.normal(k, shape, f32)

    L = DEPTH
    x = jax.random.normal(ks[0], (BATCH, SEQ, D_MODEL), f32)
    attn_norm_g = gain(ks[1], (L, D_MODEL))
    w_in = nrm(ks[2], (L, D_MODEL, D_IN), D_MODEL ** -0.5)
    rnn_conv_w = nrm(ks[3], (L, RNN_CONV, D_RNN), RNN_CONV ** -0.5)
    rnn_conv_b = nrm(ks[4], (L, D_RNN), 0.02)
    rg_wa = nrm(ks[5], (L, N_RNN_BLOCKS, RNN_BLOCK, RNN_BLOCK), RNN_BLOCK ** -0.5)
    rg_ba = nrm(ks[6], (L, D_RNN), 0.02)
    rg_wx = nrm(ks[7], (L, N_RNN_BLOCKS, RNN_BLOCK, RNN_BLOCK), RNN_BLOCK ** -0.5)
    rg_bx = nrm(ks[8], (L, D_RNN), 0.02)
    u = jax.random.uniform(ks[9], (L, D_RNN), f32, 0.9, 0.999)
    s_a = u ** (1.0 / RG_C)
    rg_lambda = jnp.log(s_a) - jnp.log1p(-s_a)
    lam_q1 = nrm(ks[10], (L, HEAD_DIM), 0.1)
    lam_k1 = nrm(ks[11], (L, HEAD_DIM), 0.1)
    lam_q2 = nrm(ks[12], (L, HEAD_DIM), 0.1)
    lam_k2 = nrm(ks[13], (L, HEAD_DIM), 0.1)
    subln_g = gain(ks[14], (L, V_HEAD_DIM))
    w_proj_rnn = nrm(ks[15], (L, D_RNN, D_MODEL), D_RNN ** -0.5)
    w_proj_attn = nrm(ks[16], (L, D_V, D_MODEL), D_V ** -0.5)
    w_out = nrm(ks[17], (L, D_MODEL, D_MODEL), D_MODEL ** -0.5)
    mlp_norm_g = gain(ks[18], (L, D_MODEL))
    w_up = nrm(ks[19], (L, D_MODEL, 2 * D_FF), D_MODEL ** -0.5)
    ffn_conv_w = nrm(ks[20], (L, FFN_CONV, D_FF), FFN_CONV ** -0.5)
    ffn_conv_b = nrm(ks[21], (L, D_FF), 0.02)
    w_down = nrm(ks[22], (L, D_FF, D_MODEL), D_FF ** -0.5)
    final_norm_g = gain(ks[23], (D_MODEL,))
    return {"x": x, "attn_norm_g": attn_norm_g, "w_in": w_in,
            "rnn_conv_w": rnn_conv_w, "rnn_conv_b": rnn_conv_b,
            "rg_wa": rg_wa, "rg_ba": rg_ba, "rg_wx": rg_wx, "rg_bx": rg_bx,
            "rg_lambda": rg_lambda, "lam_q1": lam_q1, "lam_k1": lam_k1,
            "lam_q2": lam_q2, "lam_k2": lam_k2, "subln_g": subln_g,
            "w_proj_rnn": w_proj_rnn, "w_proj_attn": w_proj_attn, "w_out": w_out,
            "mlp_norm_g": mlp_norm_g, "w_up": w_up, "ffn_conv_w": ffn_conv_w,
            "ffn_conv_b": ffn_conv_b, "w_down": w_down, "final_norm_g": final_norm_g}


def reference(x, attn_norm_g, w_in, rnn_conv_w, rnn_conv_b, rg_wa, rg_ba, rg_wx, rg_bx,
              rg_lambda, lam_q1, lam_k1, lam_q2, lam_k2, subln_g, w_proj_rnn, w_proj_attn,
              w_out, mlp_norm_g, w_up, ffn_conv_w, ffn_conv_b, w_down, final_norm_g):
    bsz, s, _ = x.shape
    for l in range(DEPTH):
        lambda_init = lambda_init_for(l)
        h = rms_norm(x, attn_norm_g[l])
        proj = h @ w_in[l]
        xr, gr, q, k, v, g_rnn, g_attn = jnp.split(proj, SPLITS, axis=-1)
        xr = causal_dwconv(xr, rnn_conv_w[l], rnn_conv_b[l])
        y_rnn = rg_lru(xr, rg_wa[l], rg_ba[l], rg_wx[l], rg_bx[l], rg_lambda[l])
        y_rnn = y_rnn * jax.nn.gelu(gr)
        lam = (jnp.exp(jnp.sum(lam_q1[l].astype(jnp.float32) * lam_k1[l].astype(jnp.float32)))
               - jnp.exp(jnp.sum(lam_q2[l].astype(jnp.float32) * lam_k2[l].astype(jnp.float32)))
               + lambda_init)
        qh = q.reshape(bsz, s, N_HEADS, 2, HEAD_DIM)
        kh = k.reshape(bsz, s, N_HEADS, 2, HEAD_DIM)
        vh = v.reshape(bsz, s, N_HEADS, V_HEAD_DIM)
        o = diff_attention(qh, kh, vh, lam)
        o = rms_norm(o, subln_g[l], eps=1e-5) * (1.0 - lambda_init)
        y_attn = o.reshape(bsz, s, D_V)
        merged = (jax.nn.sigmoid(g_rnn) * (y_rnn @ w_proj_rnn[l])
                  + jax.nn.sigmoid(g_attn) * (y_attn @ w_proj_attn[l]))
        x = x + merged @ w_out[l]
        h = rms_norm(x, mlp_norm_g[l])
        u_gate, u_val = jnp.split(h @ w_up[l], 2, axis=-1)
        u_gate = causal_dwconv(u_gate, ffn_conv_w[l], ffn_conv_b[l])
        x = x + (jax.nn.gelu(u_gate) * u_val) @ w_down[l]
    return rms_norm(x, final_norm_g)
```

```cpp
#include <hip/hip_runtime.h>
#include <hip/hip_cooperative_groups.h>
#include <cstdio>
#include <cstdint>
namespace cg = cooperative_groups;
namespace pg8 {
#define PG8_LAS __attribute__((address_space(3)))
typedef unsigned short bf16_t;
typedef short bf16x8 __attribute__((ext_vector_type(8)));
typedef float f32x4 __attribute__((ext_vector_type(4)));
typedef unsigned u32x4 __attribute__((ext_vector_type(4)));
constexpr int BM = 256, BK = 64, HALF = 128, HTB = HALF * BK * 2  , STAGE_BYTES = 8 * HTB, NXCD = 8, WGM = 8;

__host__ __device__ __forceinline__ int lds_byte(int r, int c) { const int st = (r >> 4) * 2 + (c >> 5), rr = r & 15, cc = c & 31, ob = rr * 64 + cc * 2; return st * 1024 + (ob ^ (((ob >> 9) & 1) << 5)); }
__host__ __device__ __forceinline__ void stage_rc(int b, int& R, int& C) { const int st = b / 1024, sb = b % 1024, swz = sb ^ (((sb >> 9) & 1) << 5); R = (st >> 1) * 16 + swz / 64; C = (st & 1) * 32 + (swz % 64) / 2; }
__host__ __device__ __forceinline__ int perm32(int rho) { const int n = rho >> 4, i = rho & 15; return 8 * (i >> 2) + 4 * n + (i & 3); }

struct Unit { int pm, pn; };
struct Gemm { const bf16_t* A; const bf16_t* Bt; int M, N, K; const bf16_t* A2; const bf16_t* Bt2; };

struct StaticOrder {
    int nM, nN, nwg, G, c;
    __host__ __device__ void init(int M, int N, int G_, int c_) { nM = M / BM; nN = N / BM; nwg = nM * nN; G = G_; c = c_; }
    __host__ __device__ bool next(int i, Unit& u) const {
        const long L = (long)i * G + c; if (L >= nwg) return false;
        int wgid = (int)L; { const int q = nwg / NXCD, r = nwg % NXCD, xcd = wgid % NXCD, off = wgid / NXCD; wgid = (xcd < r ? xcd * (q + 1) : r * (q + 1) + (xcd - r) * q) + off; }
        const int nig = WGM * nN, gid = wgid / nig, fm = gid * WGM, gsz = (nM - fm) < WGM ? (nM - fm) : WGM;
        u.pm = fm + ((wgid % nig) % gsz); u.pn = (wgid % nig) / gsz; return true;
    }
    __device__ __forceinline__ void a_ready(const Unit&) const {}
    __device__ __forceinline__ void done(const Unit&) const {}
};

__device__ __forceinline__ unsigned cvt_pk_bf16(float lo, float hi) { unsigned r; asm volatile("v_cvt_pk_bf16_f32 %0, %1, %2" : "=v"(r) : "v"(lo), "v"(hi)); return r; }
__device__ __forceinline__ float bf_lo(unsigned w) { return __uint_as_float(w << 16); }
__device__ __forceinline__ float bf_hi(unsigned w) { return __uint_as_float(w & 0xffff0000u); }
__device__ __forceinline__ float sigmoidf_fast(float v) { return __builtin_amdgcn_rcpf(1.0f + __builtin_amdgcn_exp2f(-1.4426950408889634f * v)); }
__device__ __forceinline__ float gelu_tanh(float v) { const float u = v * (1.0f + 0.044715f * v * v); return v * __builtin_amdgcn_rcpf(1.0f + __builtin_amdgcn_exp2f(-2.302208198f * u)); }

template <int MODE> struct Epi {
    static constexpr bool PERM = true, AFTER_DRAIN = false;
    bf16_t* O; float* F; const float* X; const bf16_t* G; float* SS; int ldo; int split_cols; size_t split_stride; int scale_tile; float scale;
    __device__ __forceinline__ void operator()(const f32x4 (&acc)[2][2][4][2], const Unit& u, int wr, int wc, int fr, int fq) const {
        const int row0 = u.pm * BM + wr * 64 + fr;
        int colt = u.pn * BM; bf16_t* obase = O; float sc = 1.f;
        if (MODE == 0 || MODE == 4) { if (split_cols) { const int t = colt / split_cols; obase += (size_t)t * split_stride; colt -= t * split_cols; if (MODE == 0 && t == scale_tile) sc = scale; } }
        const int col0 = colt + wc * 32 + 8 * fq;
        const int gcol0 = u.pn * BM + wc * 32 + 8 * fq;
#pragma unroll
        for (int ai = 0; ai < 2; ++ai)
#pragma unroll
            for (int m = 0; m < 4; ++m) {
                const int row = row0 + ai * HALF + m * 16;
                float rs = 1.f;
                if (MODE == 4) rs = __builtin_amdgcn_rsqf(SS[row] * (1.0f / 1024.0f) + 1e-6f);
                float ssq = 0.f;
#pragma unroll
                for (int bj = 0; bj < 2; ++bj) {
                    f32x4 v0 = acc[ai][bj][m][0], v1 = acc[ai][bj][m][1];
                    if (MODE == 0) { v0 = v0 * sc; v1 = v1 * sc; }
                    if (MODE == 4) { v0 = v0 * rs; v1 = v1 * rs; }
                    if (MODE == 1 || MODE == 2) {
                        const u32x4 g = *(const u32x4*)(G + (size_t)row * 1024 + gcol0 + bj * HALF);
                        v0[0] *= sigmoidf_fast(bf_lo(g.x)); v0[1] *= sigmoidf_fast(bf_hi(g.x)); v0[2] *= sigmoidf_fast(bf_lo(g.y)); v0[3] *= sigmoidf_fast(bf_hi(g.y));
                        v1[0] *= sigmoidf_fast(bf_lo(g.z)); v1[1] *= sigmoidf_fast(bf_hi(g.z)); v1[2] *= sigmoidf_fast(bf_lo(g.w)); v1[3] *= sigmoidf_fast(bf_hi(g.w));
                    }
                    if (MODE == 1) { float* fp = F + (size_t)row * 1024 + gcol0 + bj * HALF; *(f32x4*)fp = v0; *(f32x4*)(fp + 4) = v1; }
                    if (MODE == 2) { const float* fp = F + (size_t)row * 1024 + gcol0 + bj * HALF; v0 = v0 + *(const f32x4*)fp; v1 = v1 + *(const f32x4*)(fp + 4); }
                    if (MODE == 3) { const float* xp = X + (size_t)row * 1024 + gcol0 + bj * HALF; v0 = v0 + *(const f32x4*)xp; v1 = v1 + *(const f32x4*)(xp + 4);
                        ssq += (v0[0] * v0[0] + v0[1] * v0[1]) + (v0[2] * v0[2] + v0[3] * v0[3]) + (v1[0] * v1[0] + v1[1] * v1[1]) + (v1[2] * v1[2] + v1[3] * v1[3]); }
                    if (MODE == 5) { const u32x4 g = *(const u32x4*)(G + (size_t)row * 1024 + gcol0 + bj * HALF);
                        v0[0] += bf_lo(g.x); v0[1] += bf_hi(g.x); v0[2] += bf_lo(g.y); v0[3] += bf_hi(g.y); v1[0] += bf_lo(g.z); v1[1] += bf_hi(g.z); v1[2] += bf_lo(g.w); v1[3] += bf_hi(g.w);
                        ssq += (v0[0] * v0[0] + v0[1] * v0[1]) + (v0[2] * v0[2] + v0[3] * v0[3]) + (v1[0] * v1[0] + v1[1] * v1[1]) + (v1[2] * v1[2] + v1[3] * v1[3]); }
                    if (MODE == 0 || MODE == 2 || MODE == 3 || MODE == 4 || MODE == 5) {
                        u32x4 w; w.x = cvt_pk_bf16(v0[0], v0[1]); w.y = cvt_pk_bf16(v0[2], v0[3]); w.z = cvt_pk_bf16(v1[0], v1[1]); w.w = cvt_pk_bf16(v1[2], v1[3]);
                        *(u32x4*)(obase + (size_t)row * ldo + col0 + bj * HALF) = w; }
                }
                if (MODE == 3 || MODE == 5) { ssq += __shfl_xor(ssq, 16); ssq += __shfl_xor(ssq, 32); if (fq == 0) atomicAdd(SS + row, ssq); }
            }
    }
};

__device__ __forceinline__ float dpp_row_shr1(float oldv, float src) { return __builtin_bit_cast(float, __builtin_amdgcn_update_dpp(__builtin_bit_cast(int, oldv), __builtin_bit_cast(int, src), 0x111, 0xf, 0xf, false)); }
__device__ __forceinline__ float dpp_row_shr2(float oldv, float src) { return __builtin_bit_cast(float, __builtin_amdgcn_update_dpp(__builtin_bit_cast(int, oldv), __builtin_bit_cast(int, src), 0x112, 0xf, 0xf, false)); }
__device__ __forceinline__ float dpp_row_ror1(float src) { return __builtin_bit_cast(float, __builtin_amdgcn_update_dpp(0, __builtin_bit_cast(int, src), 0x121, 0xf, 0xf, false)); }
__device__ __forceinline__ float dpp_row_ror2(float src) { return __builtin_bit_cast(float, __builtin_amdgcn_update_dpp(0, __builtin_bit_cast(int, src), 0x122, 0xf, 0xf, false)); }
struct EpiAct {
    static constexpr bool PERM = true, AFTER_DRAIN = false;
    bf16_t* ACT; const float* SS; const float* cw; const float* cb; bf16_t* SG; bf16_t* SV;
    __device__ __forceinline__ void operator()(const f32x4 (&acc)[2][2][4][2], const Unit& u, int wr, int wc, int fr, int fq) const {
        const int ch0 = u.pn * 128 + wc * 32 + 8 * fq;
        float w0[8], w1[8], w2[8], bb[8];
        { const f32x4 a = *(const f32x4*)(cw + ch0), b = *(const f32x4*)(cw + ch0 + 4); w0[0] = a[0]; w0[1] = a[1]; w0[2] = a[2]; w0[3] = a[3]; w0[4] = b[0]; w0[5] = b[1]; w0[6] = b[2]; w0[7] = b[3]; }
        { const f32x4 a = *(const f32x4*)(cw + 3072 + ch0), b = *(const f32x4*)(cw + 3072 + ch0 + 4); w1[0] = a[0]; w1[1] = a[1]; w1[2] = a[2]; w1[3] = a[3]; w1[4] = b[0]; w1[5] = b[1]; w1[6] = b[2]; w1[7] = b[3]; }
        { const f32x4 a = *(const f32x4*)(cw + 6144 + ch0), b = *(const f32x4*)(cw + 6144 + ch0 + 4); w2[0] = a[0]; w2[1] = a[1]; w2[2] = a[2]; w2[3] = a[3]; w2[4] = b[0]; w2[5] = b[1]; w2[6] = b[2]; w2[7] = b[3]; }
        { const f32x4 a = *(const f32x4*)(cb + ch0), b = *(const f32x4*)(cb + ch0 + 4); bb[0] = a[0]; bb[1] = a[1]; bb[2] = a[2]; bb[3] = a[3]; bb[4] = b[0]; bb[5] = b[1]; bb[6] = b[2]; bb[7] = b[3]; }
        float ssr[2][4];
#pragma unroll
        for (int ai = 0; ai < 2; ++ai)
#pragma unroll
            for (int m = 0; m < 4; ++m) ssr[ai][m] = SS[(u.pm * 4 + ai * 2 + wr) * 64 + m * 16 + fr];
#pragma unroll
        for (int ai = 0; ai < 2; ++ai) {
            const int strip = u.pm * 4 + ai * 2 + wr;
            float gp[8];
#pragma unroll
            for (int e = 0; e < 8; ++e) gp[e] = 0.f;
#pragma unroll
            for (int m = 0; m < 4; ++m) {
                const int row = strip * 64 + m * 16 + fr;
                const float rs = __builtin_amdgcn_rsqf(ssr[ai][m] * (1.0f / 1024.0f) + 1e-6f);
                float g[8], v[8], o[8];
#pragma unroll
                for (int e = 0; e < 4; ++e) { g[e] = acc[ai][0][m][0][e] * rs; g[4 + e] = acc[ai][0][m][1][e] * rs; v[e] = acc[ai][1][m][0][e] * rs; v[4 + e] = acc[ai][1][m][1][e] * rs; }
#pragma unroll
                for (int e = 0; e < 8; e += 2) { typedef float f2 __attribute__((ext_vector_type(2)));
                    const f2 r1 = (f2){dpp_row_shr1(dpp_row_ror1(gp[e]), g[e]), dpp_row_shr1(dpp_row_ror1(gp[e + 1]), g[e + 1])};
                    const f2 r2 = (f2){dpp_row_shr2(dpp_row_ror2(gp[e]), g[e]), dpp_row_shr2(dpp_row_ror2(gp[e + 1]), g[e + 1])};
                    const f2 c = (f2){bb[e], bb[e + 1]} + (f2){w0[e], w0[e + 1]} * r2 + (f2){w1[e], w1[e + 1]} * r1 + (f2){w2[e], w2[e + 1]} * (f2){g[e], g[e + 1]};
                    f2 t = c * (c * c * 0.044715f + 1.0f) * (-2.302208198f);
                    t.x = __builtin_amdgcn_exp2f(t.x); t.y = __builtin_amdgcn_exp2f(t.y); t = t + 1.0f;
                    f2 q; q.x = __builtin_amdgcn_rcpf(t.x); q.y = __builtin_amdgcn_rcpf(t.y);
                    const f2 ov = c * q * (f2){v[e], v[e + 1]}; o[e] = ov.x; o[e + 1] = ov.y; }
                u32x4 w; w.x = cvt_pk_bf16(o[0], o[1]); w.y = cvt_pk_bf16(o[2], o[3]); w.z = cvt_pk_bf16(o[4], o[5]); w.w = cvt_pk_bf16(o[6], o[7]);
                *(u32x4*)(ACT + (size_t)row * 3072 + ch0) = w;
                if (m == 0 && fr < 2) { u32x4 gw, vw; gw.x = cvt_pk_bf16(g[0], g[1]); gw.y = cvt_pk_bf16(g[2], g[3]); gw.z = cvt_pk_bf16(g[4], g[5]); gw.w = cvt_pk_bf16(g[6], g[7]);
                    vw.x = cvt_pk_bf16(v[0], v[1]); vw.y = cvt_pk_bf16(v[2], v[3]); vw.z = cvt_pk_bf16(v[4], v[5]); vw.w = cvt_pk_bf16(v[6], v[7]);
                    *(u32x4*)(SG + ((size_t)strip * 4 + 2 + fr) * 3072 + ch0) = gw; *(u32x4*)(SV + ((size_t)strip * 2 + fr) * 3072 + ch0) = vw; }
                if (m == 3 && fr >= 14) { u32x4 gw; gw.x = cvt_pk_bf16(g[0], g[1]); gw.y = cvt_pk_bf16(g[2], g[3]); gw.z = cvt_pk_bf16(g[4], g[5]); gw.w = cvt_pk_bf16(g[6], g[7]);
                    *(u32x4*)(SG + ((size_t)strip * 4 + (fr - 14)) * 3072 + ch0) = gw; }
#pragma unroll
                for (int e = 0; e < 8; ++e) gp[e] = g[e];
            }
        }
    }
};


#define PG8_FENCE() asm volatile("" ::: "memory")
struct EpiRes3 {
    static constexpr bool PERM = true, AFTER_DRAIN = false;
    bf16_t* O; const float* X; float* SS;
    __device__ __forceinline__ void operator()(const f32x4 (&acc)[2][2][4][2], const Unit& u, int wr, int wc, int fr, int fq) const {
        const int row0 = u.pm * BM + wr * 64 + fr, col0 = u.pn * BM + wc * 32 + 8 * fq;
        f32x4 xb[2][2][2][2];
#define PG8_LDX(buf, b) do { const int ai_ = (b) >> 1, mp_ = (b) & 1; _Pragma("unroll") for (int mm = 0; mm < 2; ++mm) _Pragma("unroll") for (int bj = 0; bj < 2; ++bj) { \
            const float* xp = X + (size_t)(row0 + ai_ * HALF + (mp_ * 2 + mm) * 16) * 1024 + col0 + bj * HALF; xb[buf][mm][bj][0] = *(const f32x4*)xp; xb[buf][mm][bj][1] = *(const f32x4*)(xp + 4); } } while (0)
        PG8_LDX(0, 0);
#pragma unroll
        for (int b = 0; b < 4; ++b) {
            if (b + 1 < 4) { if ((b & 1) == 0) PG8_LDX(1, b + 1); else PG8_LDX(0, b + 1); }
            PG8_FENCE();
            const int ai = b >> 1, mp = b & 1;
#pragma unroll
            for (int mm = 0; mm < 2; ++mm) { const int m = mp * 2 + mm, row = row0 + ai * HALF + m * 16; float ssq = 0.f;
#pragma unroll
                for (int bj = 0; bj < 2; ++bj) { const f32x4 v0 = acc[ai][bj][m][0] + xb[b & 1][mm][bj][0], v1 = acc[ai][bj][m][1] + xb[b & 1][mm][bj][1];
                    ssq += (v0[0] * v0[0] + v0[1] * v0[1]) + (v0[2] * v0[2] + v0[3] * v0[3]) + (v1[0] * v1[0] + v1[1] * v1[1]) + (v1[2] * v1[2] + v1[3] * v1[3]);
                    u32x4 w; w.x = cvt_pk_bf16(v0[0], v0[1]); w.y = cvt_pk_bf16(v0[2], v0[3]); w.z = cvt_pk_bf16(v1[0], v1[1]); w.w = cvt_pk_bf16(v1[2], v1[3]);
                    *(u32x4*)(O + (size_t)row * 1024 + col0 + bj * HALF) = w; }
                ssq += __shfl_xor(ssq, 16); ssq += __shfl_xor(ssq, 32); if (fq == 0) atomicAdd(SS + row, ssq); }
            PG8_FENCE();
        }
#undef PG8_LDX
    }
};
struct EpiRes5 {
    static constexpr bool PERM = true, AFTER_DRAIN = false;
    bf16_t* O; const bf16_t* G; float* SS;
    __device__ __forceinline__ void operator()(const f32x4 (&acc)[2][2][4][2], const Unit& u, int wr, int wc, int fr, int fq) const {
        const int row0 = u.pm * BM + wr * 64 + fr, col0 = u.pn * BM + wc * 32 + 8 * fq;
        u32x4 gb[2][4][2];
#pragma unroll
        for (int ai = 0; ai < 2; ++ai)
#pragma unroll
            for (int m = 0; m < 4; ++m)
#pragma unroll
                for (int bj = 0; bj < 2; ++bj) gb[ai][m][bj] = *(const u32x4*)(G + (size_t)(row0 + ai * HALF + m * 16) * 1024 + col0 + bj * HALF);
        PG8_FENCE();
#pragma unroll
        for (int ai = 0; ai < 2; ++ai)
#pragma unroll
            for (int m = 0; m < 4; ++m) { const int row = row0 + ai * HALF + m * 16; float ssq = 0.f;
#pragma unroll
                for (int bj = 0; bj < 2; ++bj) { const u32x4 g = gb[ai][m][bj]; f32x4 v0 = acc[ai][bj][m][0], v1 = acc[ai][bj][m][1];
                    v0[0] += bf_lo(g.x); v0[1] += bf_hi(g.x); v0[2] += bf_lo(g.y); v0[3] += bf_hi(g.y); v1[0] += bf_lo(g.z); v1[1] += bf_hi(g.z); v1[2] += bf_lo(g.w); v1[3] += bf_hi(g.w);
                    ssq += (v0[0] * v0[0] + v0[1] * v0[1]) + (v0[2] * v0[2] + v0[3] * v0[3]) + (v1[0] * v1[0] + v1[1] * v1[1]) + (v1[2] * v1[2] + v1[3] * v1[3]);
                    u32x4 w; w.x = cvt_pk_bf16(v0[0], v0[1]); w.y = cvt_pk_bf16(v0[2], v0[3]); w.z = cvt_pk_bf16(v1[0], v1[1]); w.w = cvt_pk_bf16(v1[2], v1[3]);
                    *(u32x4*)(O + (size_t)row * 1024 + col0 + bj * HALF) = w; }
                ssq += __shfl_xor(ssq, 16); ssq += __shfl_xor(ssq, 32); if (fq == 0) atomicAdd(SS + row, ssq); }
    }
};


struct EpiRes5F {
    static constexpr bool PERM = true, AFTER_DRAIN = false;
    float* OUT; const bf16_t* G; float* SS; const float* gf; unsigned* cnt;
    __device__ __forceinline__ void operator()(const f32x4 (&acc)[2][2][4][2], const Unit& u, int wr, int wc, int fr, int fq) const {
        const int row0 = u.pm * BM + wr * 64 + fr, col0 = u.pn * BM + wc * 32 + 8 * fq;
        u32x4 gb[2][4][2];
#pragma unroll
        for (int ai = 0; ai < 2; ++ai)
#pragma unroll
            for (int m = 0; m < 4; ++m)
#pragma unroll
                for (int bj = 0; bj < 2; ++bj) gb[ai][m][bj] = *(const u32x4*)(G + (size_t)(row0 + ai * HALF + m * 16) * 1024 + col0 + bj * HALF);
        PG8_FENCE();
        f32x4 v[2][4][2][2];
#pragma unroll
        for (int ai = 0; ai < 2; ++ai)
#pragma unroll
            for (int m = 0; m < 4; ++m) { const int row = row0 + ai * HALF + m * 16; float ssq = 0.f;
#pragma unroll
                for (int bj = 0; bj < 2; ++bj) { const u32x4 g = gb[ai][m][bj]; f32x4 v0 = acc[ai][bj][m][0], v1 = acc[ai][bj][m][1];
                    v0[0] += bf_lo(g.x); v0[1] += bf_hi(g.x); v0[2] += bf_lo(g.y); v0[3] += bf_hi(g.y); v1[0] += bf_lo(g.z); v1[1] += bf_hi(g.z); v1[2] += bf_lo(g.w); v1[3] += bf_hi(g.w);
                    ssq += (v0[0] * v0[0] + v0[1] * v0[1]) + (v0[2] * v0[2] + v0[3] * v0[3]) + (v1[0] * v1[0] + v1[1] * v1[1]) + (v1[2] * v1[2] + v1[3] * v1[3]);
                    v[ai][m][bj][0] = v0; v[ai][m][bj][1] = v1; }
                ssq += __shfl_xor(ssq, 16); ssq += __shfl_xor(ssq, 32); if (fq == 0) atomicAdd(SS + row, ssq); }
        asm volatile("s_waitcnt vmcnt(0)" ::: "memory");
        unsigned* pc = cnt + 64 * u.pm;
        if (fr == 0 && fq == 0) __hip_atomic_fetch_add(pc, 1u, __ATOMIC_RELAXED, __HIP_MEMORY_SCOPE_AGENT);
        f32x4 gv[2][2];
#pragma unroll
        for (int bj = 0; bj < 2; ++bj) { gv[bj][0] = *(const f32x4*)(gf + col0 + bj * HALF); gv[bj][1] = *(const f32x4*)(gf + col0 + bj * HALF + 4); }
        { unsigned sp = 0;
          while ((unsigned)__builtin_amdgcn_readfirstlane(__hip_atomic_load(pc, __ATOMIC_RELAXED, __HIP_MEMORY_SCOPE_AGENT)) < 32u) { __builtin_amdgcn_s_sleep(2); if (++sp > (1u << 20)) break; } }
        PG8_FENCE();
        float ssr[2][4];
#pragma unroll
        for (int ai = 0; ai < 2; ++ai)
#pragma unroll
            for (int m = 0; m < 4; ++m) ssr[ai][m] = __hip_atomic_load(SS + row0 + ai * HALF + m * 16, __ATOMIC_RELAXED, __HIP_MEMORY_SCOPE_AGENT);
        PG8_FENCE();
#pragma unroll
        for (int ai = 0; ai < 2; ++ai)
#pragma unroll
            for (int m = 0; m < 4; ++m) { const int row = row0 + ai * HALF + m * 16;
                const float rs = __builtin_amdgcn_rsqf(ssr[ai][m] * (1.0f / 1024.0f) + 1e-6f);
#pragma unroll
                for (int bj = 0; bj < 2; ++bj) { float* op = OUT + (size_t)row * 1024 + col0 + bj * HALF;
                    *(f32x4*)op = v[ai][m][bj][0] * rs * gv[bj][0]; *(f32x4*)(op + 4) = v[ai][m][bj][1] * rs * gv[bj][1]; } }
    }
};
struct RoundOrder {
    StaticOrder base; int k;
    __device__ __forceinline__ bool next(int i, Unit& u) const { return i == 0 ? base.next(k, u) : false; }
    __device__ __forceinline__ void a_ready(const Unit&) const {}
    __device__ __forceinline__ void done(const Unit&) const {}
};

struct EpiMerge {
    static constexpr bool PERM = true, AFTER_DRAIN = false;
    bf16_t* O; const bf16_t* G1; const bf16_t* G2;
    __device__ __forceinline__ void mid(f32x4 (&acc)[2][2][4][2], const Unit& u, int wr, int wc, int fr, int fq) const {
        const int row0 = u.pm * BM + wr * 64 + fr, gcol0 = u.pn * BM + wc * 32 + 8 * fq;
#pragma unroll
        for (int ai = 0; ai < 2; ++ai) {
            u32x4 ga[4][2], gb[4][2];
#pragma unroll
            for (int m = 0; m < 4; ++m)
#pragma unroll
                for (int bj = 0; bj < 2; ++bj) { const size_t off = (size_t)(row0 + ai * HALF + m * 16) * 1024 + gcol0 + bj * HALF; ga[m][bj] = *(const u32x4*)(G1 + off); gb[m][bj] = *(const u32x4*)(G2 + off); }
            PG8_FENCE();
#pragma unroll
            for (int m = 0; m < 4; ++m)
#pragma unroll
                for (int bj = 0; bj < 2; ++bj) { const u32x4 a = ga[m][bj], b = gb[m][bj];
                    const unsigned A[4] = {a.x, a.y, a.z, a.w}, B[4] = {b.x, b.y, b.z, b.w};
#pragma unroll
                    for (int q = 0; q < 4; ++q) { const float nl = -1.4426950408889634f;
                        const float r0 = (1.0f + __builtin_amdgcn_exp2f(nl * bf_lo(B[q]))) * __builtin_amdgcn_rcpf(1.0f + __builtin_amdgcn_exp2f(nl * bf_lo(A[q])));
                        const float r1 = (1.0f + __builtin_amdgcn_exp2f(nl * bf_hi(B[q]))) * __builtin_amdgcn_rcpf(1.0f + __builtin_amdgcn_exp2f(nl * bf_hi(A[q])));
                        acc[ai][bj][m][q >> 1][(q & 1) * 2] *= r0; acc[ai][bj][m][q >> 1][(q & 1) * 2 + 1] *= r1; } }
            PG8_FENCE();
        }
    }
    __device__ __forceinline__ void operator()(const f32x4 (&acc)[2][2][4][2], const Unit& u, int wr, int wc, int fr, int fq) const {
        const int row0 = u.pm * BM + wr * 64 + fr, gcol0 = u.pn * BM + wc * 32 + 8 * fq;
        u32x4 gall[2][4][2];
#pragma unroll
        for (int ai = 0; ai < 2; ++ai)
#pragma unroll
            for (int m = 0; m < 4; ++m)
#pragma unroll
                for (int bj = 0; bj < 2; ++bj) gall[ai][m][bj] = *(const u32x4*)(G2 + (size_t)(row0 + ai * HALF + m * 16) * 1024 + gcol0 + bj * HALF);
        PG8_FENCE();
#pragma unroll
        for (int ai = 0; ai < 2; ++ai)
#pragma unroll
            for (int m = 0; m < 4; ++m)
#pragma unroll
                for (int bj = 0; bj < 2; ++bj) { const size_t off = (size_t)(row0 + ai * HALF + m * 16) * 1024 + gcol0 + bj * HALF;
                    const u32x4 b = gall[ai][m][bj]; const f32x4 v0 = acc[ai][bj][m][0], v1 = acc[ai][bj][m][1];
                    u32x4 w; w.x = cvt_pk_bf16(v0[0] * sigmoidf_fast(bf_lo(b.x)), v0[1] * sigmoidf_fast(bf_hi(b.x))); w.y = cvt_pk_bf16(v0[2] * sigmoidf_fast(bf_lo(b.y)), v0[3] * sigmoidf_fast(bf_hi(b.y)));
                    w.z = cvt_pk_bf16(v1[0] * sigmoidf_fast(bf_lo(b.z)), v1[1] * sigmoidf_fast(bf_hi(b.z))); w.w = cvt_pk_bf16(v1[2] * sigmoidf_fast(bf_lo(b.w)), v1[3] * sigmoidf_fast(bf_hi(b.w)));
                    *(u32x4*)(O + off) = w; }
    }
};

template <class Epi, class Sched, bool ALIGN_EPI = false, bool SP2 = false, bool PAIR = false>
__device__ __forceinline__ void gemm_phase(PG8_LAS unsigned char* lds, const Gemm g, const Sched& S, const Epi& E) {
    int tid_l = threadIdx.x; asm volatile("" : "+v"(tid_l));
    const int tid = tid_l, wid = __builtin_amdgcn_readfirstlane(tid >> 6), lane = tid & 63, wr = wid >> 2, wc = wid & 3, fr = lane & 15, fq = lane >> 4;
    const int K = g.K, nt = K / BK;
    unsigned voffA[2], voffB[2];
#pragma unroll
    for (int i = 0; i < 2; ++i) { int R, C; stage_rc(tid * 16 + i * 8192, R, C); const int Rb = Epi::PERM ? ((R & ~31) + perm32(R & 31)) : R;
        voffA[i] = (unsigned)(R * K + C) * 2u; voffB[i] = (unsigned)(Rb * K + C) * 2u; }
    const size_t kstep = (size_t)(BK * 2);
    const size_t hstep = (size_t)HALF * K * 2;
    const size_t tstep = 2 * hstep;
    const unsigned ldsw = (unsigned)wid * 1024u;
    const int aoff = lds_byte(wr * 64 + fr, fq * 8), boff = lds_byte(wc * 32 + fr, fq * 8);
#define PG8_SA(b, h) (((b) * 2 + (h)) * HTB)
#define PG8_SB(b, h) ((4 + (b) * 2 + (h)) * HTB)
#define PG8_STAGE(bufoff, gbase, voff) do { _Pragma("unroll") for (int _i = 0; _i < 2; ++_i) \
        __builtin_amdgcn_global_load_lds((const unsigned*)((const char*)(gbase) + (voff)[_i]), (PG8_LAS unsigned*)(lds + (bufoff) + ldsw + _i * 8192), 16, 0, 0); } while (0)
#define PG8_LDA(dst, b, h) do { _Pragma("unroll") for (int m = 0; m < 4; ++m) _Pragma("unroll") for (int k = 0; k < 2; ++k) dst[m][k] = *(const PG8_LAS bf16x8*)(lds + PG8_SA(b, h) + aoff + m * 2048 + k * 1024); } while (0)
#define PG8_LDB(dst, b, h) do { _Pragma("unroll") for (int n = 0; n < 2; ++n) _Pragma("unroll") for (int k = 0; k < 2; ++k) dst[n][k] = *(const PG8_LAS bf16x8*)(lds + PG8_SB(b, h) + boff + n * 2048 + k * 1024); } while (0)
#define PG8_MMA(ai, bj, At, Bt) do { __builtin_amdgcn_s_setprio(1); _Pragma("unroll") for (int m = 0; m < 4; ++m) _Pragma("unroll") for (int n = 0; n < 2; ++n) _Pragma("unroll") for (int k = 0; k < 2; ++k) \
        acc[ai][bj][m][n] = __builtin_amdgcn_mfma_f32_16x16x32_bf16(Bt[n][k], At[m][k], acc[ai][bj][m][n], 0, 0, 0); __builtin_amdgcn_s_setprio(0); } while (0)
#define PG8_WAIT_V(n) asm volatile("s_waitcnt vmcnt(" #n ")" ::: "memory")
#define PG8_WAIT_L(n) asm volatile("s_waitcnt lgkmcnt(" #n ")" ::: "memory")
#define PG8_BAR __builtin_amdgcn_s_barrier()
#define PG8_SCHED __builtin_amdgcn_sched_barrier(0)
    Unit cur, nxt; int ui = 0;
    if (!S.next(0, cur)) return;
    f32x4 acc[2][2][4][2];
#pragma unroll
    for (int a = 0; a < 2; ++a)
#pragma unroll
        for (int b = 0; b < 2; ++b)
#pragma unroll
            for (int m = 0; m < 4; ++m)
#pragma unroll
                for (int n = 0; n < 2; ++n) acc[a][b][m][n] = (f32x4){0.f, 0.f, 0.f, 0.f};
    bf16x8 At[4][2], B0[2][2], B1[2][2];
    const char* cA = (const char*)g.A + (size_t)cur.pm * tstep; const char* cB = (const char*)g.Bt + (size_t)cur.pn * tstep;
    S.a_ready(cur);
    if constexpr (SP2) {
        PG8_STAGE(PG8_SB(0, 0), cB, voffB); PG8_STAGE(PG8_SB(0, 1), cB + hstep, voffB); PG8_STAGE(PG8_SA(0, 0), cA, voffA); PG8_STAGE(PG8_SA(0, 1), cA + hstep, voffA);
        if (wr == 1) PG8_BAR;
        PG8_WAIT_V(2); PG8_BAR;
        PG8_STAGE(PG8_SB(1, 0), cB + kstep, voffB); PG8_STAGE(PG8_SA(1, 0), cA + kstep, voffA); PG8_STAGE(PG8_SB(1, 1), cB + hstep + kstep, voffB);
        PG8_WAIT_V(6); PG8_BAR;
    } else {
        PG8_STAGE(PG8_SB(0, 0), cB, voffB); PG8_STAGE(PG8_SA(0, 0), cA, voffA); PG8_STAGE(PG8_SB(0, 1), cB + hstep, voffB); PG8_STAGE(PG8_SA(0, 1), cA + hstep, voffA);
        if (wr == 1) PG8_BAR;
        PG8_WAIT_V(4); PG8_BAR;
        PG8_STAGE(PG8_SB(1, 0), cB + kstep, voffB); PG8_STAGE(PG8_SA(1, 0), cA + kstep, voffA); PG8_STAGE(PG8_SB(1, 1), cB + hstep + kstep, voffB);
        PG8_WAIT_V(6); PG8_BAR;
    }
    for (;;) {
        const bool has_next = PAIR ? S.next((ui + 1) >> 1, nxt) : S.next(ui + 1, nxt);
        const bf16_t* gA_n = (PAIR && ((ui + 1) & 1)) ? g.A2 : g.A; const bf16_t* gB_n = (PAIR && ((ui + 1) & 1)) ? g.Bt2 : g.Bt;
        const char* nA = has_next ? (const char*)gA_n + (size_t)nxt.pm * tstep : cA; const char* nB = has_next ? (const char*)gB_n + (size_t)nxt.pn * tstep : cB;
        for (int t = 0; t < nt; t += 2) {
            const bool last = (t == nt - 2);
            const char* a1 = cA + (size_t)(t + 1) * kstep;
            const char* a2 = last ? nA : cA + (size_t)(t + 2) * kstep; const char* b2 = last ? nB : cB + (size_t)(t + 2) * kstep;
            const char* a3 = a2 + kstep; const char* b3 = b2 + kstep;
            if (last && has_next) S.a_ready(nxt);
            if constexpr (SP2) {
            PG8_LDB(B0, 0, 0); PG8_LDB(B1, 0, 1); PG8_SCHED; PG8_LDA(At, 0, 0); PG8_STAGE(PG8_SA(1, 1), a1 + hstep, voffA);
            PG8_WAIT_V(8); PG8_WAIT_L(0); PG8_BAR; PG8_MMA(0, 0, At, B0); PG8_MMA(0, 1, At, B1); PG8_BAR; PG8_SCHED;
            PG8_LDA(At, 0, 1); PG8_STAGE(PG8_SB(0, 0), b2, voffB); PG8_STAGE(PG8_SB(0, 1), b2 + hstep, voffB); PG8_STAGE(PG8_SA(0, 0), a2, voffA);
            PG8_WAIT_V(8); PG8_WAIT_L(0); PG8_BAR; PG8_MMA(1, 0, At, B0); PG8_MMA(1, 1, At, B1); PG8_BAR; PG8_SCHED;
            PG8_LDB(B0, 1, 0); PG8_LDB(B1, 1, 1); PG8_SCHED; PG8_LDA(At, 1, 0); PG8_STAGE(PG8_SA(0, 1), a2 + hstep, voffA);
            PG8_WAIT_V(8); PG8_WAIT_L(0); PG8_BAR; PG8_MMA(0, 0, At, B0); PG8_MMA(0, 1, At, B1); PG8_BAR; PG8_SCHED;
            PG8_LDA(At, 1, 1); PG8_STAGE(PG8_SB(1, 0), b3, voffB); PG8_STAGE(PG8_SB(1, 1), b3 + hstep, voffB); PG8_STAGE(PG8_SA(1, 0), a3, voffA);
            PG8_WAIT_V(8); PG8_WAIT_L(0); PG8_BAR; PG8_MMA(1, 0, At, B0); PG8_MMA(1, 1, At, B1); PG8_BAR; PG8_SCHED;
            } else {
            PG8_LDB(B0, 0, 0); PG8_SCHED; PG8_LDA(At, 0, 0); PG8_STAGE(PG8_SA(1, 1), a1 + hstep, voffA);
            PG8_WAIT_L(8); PG8_BAR; PG8_WAIT_L(0); PG8_MMA(0, 0, At, B0); PG8_BAR; PG8_SCHED;
            PG8_LDB(B1, 0, 1); PG8_STAGE(PG8_SB(0, 0), b2, voffB);
            PG8_BAR; PG8_WAIT_L(0); PG8_MMA(0, 1, At, B1); PG8_BAR;
            PG8_LDA(At, 0, 1); PG8_STAGE(PG8_SA(0, 0), a2, voffA);
            PG8_BAR; PG8_WAIT_L(0); PG8_MMA(1, 0, At, B0); PG8_BAR; PG8_SCHED;
            PG8_STAGE(PG8_SB(0, 1), b2 + hstep, voffB);
            PG8_WAIT_V(6); PG8_BAR; PG8_MMA(1, 1, At, B1); PG8_BAR;
            PG8_LDB(B0, 1, 0); PG8_SCHED; PG8_LDA(At, 1, 0); PG8_STAGE(PG8_SA(0, 1), a2 + hstep, voffA);
            PG8_WAIT_L(8); PG8_BAR; PG8_WAIT_L(0); PG8_MMA(0, 0, At, B0); PG8_BAR; PG8_SCHED;
            PG8_LDB(B1, 1, 1); PG8_STAGE(PG8_SB(1, 0), b3, voffB);
            PG8_BAR; PG8_WAIT_L(0); PG8_MMA(0, 1, At, B1); PG8_BAR;
            PG8_LDA(At, 1, 1); PG8_STAGE(PG8_SA(1, 0), a3, voffA);
            PG8_BAR; PG8_WAIT_L(0); PG8_MMA(1, 0, At, B0); PG8_BAR; PG8_SCHED;
            PG8_STAGE(PG8_SB(1, 1), b3 + hstep, voffB);
            PG8_WAIT_V(6); PG8_BAR; PG8_MMA(1, 1, At, B1); PG8_BAR;
            }
        }
        if constexpr (ALIGN_EPI) { if (wr == 0) PG8_BAR; }
        if constexpr (PAIR) { if ((ui & 1) == 0) E.mid(acc, cur, wr, wc, fr, fq); else E(acc, cur, wr, wc, fr, fq); }
        else if constexpr (!Epi::AFTER_DRAIN) { E(acc, cur, wr, wc, fr, fq); S.done(cur); }
        if (!has_next) break;
        if (!(PAIR && (ui & 1) == 0))
#pragma unroll
        for (int a = 0; a < 2; ++a)
#pragma unroll
            for (int b = 0; b < 2; ++b)
#pragma unroll
                for (int m = 0; m < 4; ++m)
#pragma unroll
                    for (int n = 0; n < 2; ++n) acc[a][b][m][n] = (f32x4){0.f, 0.f, 0.f, 0.f};
        cur = nxt; cA = nA; cB = nB; ++ui;
        if constexpr (ALIGN_EPI) { if (wr == 1) PG8_BAR; }
    }
    PG8_WAIT_V(0);
    if constexpr (!ALIGN_EPI) { if (wr == 0) PG8_BAR; }
    PG8_BAR;
    if constexpr (Epi::AFTER_DRAIN) { E.fused(acc, cur, wr, wc, fr, fq, lds, wid, lane); S.done(cur); }
#undef PG8_SA
#undef PG8_SB
#undef PG8_STAGE
#undef PG8_LDA
#undef PG8_LDB
#undef PG8_MMA
#undef PG8_WAIT_V
#undef PG8_WAIT_L
#undef PG8_BAR
#undef PG8_SCHED
}
}

#include <hip/hip_bf16.h>
#include <cmath>
namespace attn_body {
using bf16=__hip_bfloat16;
using bf16x8=__attribute__((ext_vector_type(8)))short;
using s16x4=__attribute__((ext_vector_type(4)))short;
using f32x16=__attribute__((ext_vector_type(16)))float;
using u32x4=__attribute__((ext_vector_type(4)))unsigned;
constexpr int BATCH=4,NHEAD=16,SEQ=8192,D=64,DM=NHEAD*D;
constexpr int NW=8,QBLK=32,QB=QBLK*NW,KVBLK=64,NQB=SEQ/QB;
constexpr int ATTN_PITCH=DM, ATTN_UNIT_ROWS=QB;
__device__ __forceinline__ int crow(int r,int hi){return (r&3)+8*(r>>2)+4*hi;}
#define SBAR() __builtin_amdgcn_sched_barrier(0)
__device__ __forceinline__ void cmask(f32x16&p0,f32x16&p1,int jb,int qrel,int hi){
  const float NEG=-INFINITY; int kb=64*jb+4*hi;
  #pragma unroll
  for(int r=0;r<16;++r){int kv=kb+(r&3)+8*(r>>2); if(kv>qrel)p0[r]=NEG; if(kv+32>qrel)p1[r]=NEG;}
}

constexpr int NSLOT=3, SLOTB=8192;
constexpr int LDS_K=0, LDS_V=NSLOT*SLOTB, LDS_WS=2*NSLOT*SLOTB, LDS_OST=LDS_WS+NW*64*4, LDS_BYTES=LDS_OST+NW*4096;
constexpr float C2=0.125f*1.4426950408889634f;
__device__ __forceinline__ void glds16(const void*gsrc,unsigned lds_dst){unsigned keep;
  asm volatile("s_mov_b32 %0, m0\n\ts_mov_b32 m0, %2\n\ts_nop 0\n\tglobal_load_lds_dwordx4 %1, off\n\ts_mov_b32 m0, %0":"=&s"(keep):"v"(gsrc),"s"(lds_dst):"memory");}
__device__ __forceinline__ float max3f(float a,float b,float c){float r;asm("v_max3_f32 %0, %1, %2, %3":"=v"(r):"v"(a),"v"(b),"v"(c));return r;}
__device__ __forceinline__ float max2f(float a,float b){float r;asm("v_max_f32_e32 %0, %1, %2":"=v"(r):"v"(a),"v"(b));return r;}
__device__ __forceinline__ float fadd_s(float a,float b){float r;asm("v_add_f32_e32 %0, %1, %2":"=v"(r):"v"(a),"v"(b));return r;}
__device__ __forceinline__ float fsub_s(float a,float b){float r;asm("v_sub_f32_e32 %0, %1, %2":"=v"(r):"v"(a),"v"(b));return r;}
typedef float f32x2_t __attribute__((ext_vector_type(2))); typedef __bf16 bf16x2_t __attribute__((ext_vector_type(2)));
__device__ __forceinline__ unsigned cvtpk_s(float lo,float hi){f32x2_t v={lo,hi};bf16x2_t b=__builtin_convertvector(v,bf16x2_t);return __builtin_bit_cast(unsigned,b);}
#define WAIT_BAR(N) asm volatile("s_waitcnt vmcnt(" #N ") lgkmcnt(0)\n\ts_barrier":::"memory")

__device__ __forceinline__ void qkt(f32x16&p0,f32x16&p1,const char*Kslot,const bf16x8*qr,const f32x16&negm,int r32,int hi){
  const char*kb=Kslot+hi*1024+r32*16;
  #pragma unroll
  for(int d0=0;d0<4;++d0){
    const bf16x8 b0=*reinterpret_cast<const bf16x8*>(kb+d0*2048);
    const bf16x8 b1=*reinterpret_cast<const bf16x8*>(kb+d0*2048+512);
    if(d0==0){p0=__builtin_amdgcn_mfma_f32_32x32x16_bf16(b0,qr[0],negm,0,0,0);p1=__builtin_amdgcn_mfma_f32_32x32x16_bf16(b1,qr[0],negm,0,0,0);}
    else{p0=__builtin_amdgcn_mfma_f32_32x32x16_bf16(b0,qr[d0],p0,0,0,0);p1=__builtin_amdgcn_mfma_f32_32x32x16_bf16(b1,qr[d0],p1,0,0,0);}}
}
typedef __attribute__((address_space(3))) const char* lds_cptr;
typedef short v4i16_t __attribute__((ext_vector_type(4)));
__device__ __forceinline__ void kload8(bf16x8*kf,lds_cptr kp){
  kf[0]=*(const __attribute__((address_space(3))) bf16x8*)(kp);      kf[1]=*(const __attribute__((address_space(3))) bf16x8*)(kp+512);
  kf[2]=*(const __attribute__((address_space(3))) bf16x8*)(kp+2048); kf[3]=*(const __attribute__((address_space(3))) bf16x8*)(kp+2560);
  kf[4]=*(const __attribute__((address_space(3))) bf16x8*)(kp+4096); kf[5]=*(const __attribute__((address_space(3))) bf16x8*)(kp+4608);
  kf[6]=*(const __attribute__((address_space(3))) bf16x8*)(kp+6144); kf[7]=*(const __attribute__((address_space(3))) bf16x8*)(kp+6656);
}
__device__ __forceinline__ void kload2(bf16x8*kf,lds_cptr kp,int j){ kf[2*j]=*(const __attribute__((address_space(3))) bf16x8*)(kp+j*2048); kf[2*j+1]=*(const __attribute__((address_space(3))) bf16x8*)(kp+j*2048+512); }
__device__ __forceinline__ s16x4 vtr(lds_cptr p){ return __builtin_bit_cast(s16x4,__builtin_amdgcn_ds_read_tr16_b64_v4i16((__attribute__((address_space(3))) v4i16_t*)p)); }
__device__ __forceinline__ float rowmax(const f32x16&p0,const f32x16&p1){
  float a=max3f(p0[0],p0[1],p1[0]),b=max3f(p0[2],p0[3],p1[1]);a=max3f(a,p1[2],p1[3]);
  #pragma unroll
  for(int r=4;r<16;r+=4){a=max3f(a,p0[r],p0[r+1]);b=max3f(b,p0[r+2],p0[r+3]);a=max3f(a,p1[r],p1[r+1]);b=max3f(b,p1[r+2],p1[r+3]);}
  const float m=max2f(a,b);
  auto rr=__builtin_amdgcn_permlane32_swap(__float_as_uint(m),__float_as_uint(m),false,false);
  return max2f(__uint_as_float(rr[0]),__uint_as_float(rr[1]));
}
__device__ __forceinline__ void pv(f32x16*o,int vb,bf16x8 pa0,bf16x8 pa1,bf16x8 pa2,bf16x8 pa3){
  #pragma unroll
  for(int d0=0;d0<2;++d0){s16x4 lo[4],hi[4];
    #pragma unroll
    for(int ks=0;ks<4;++ks){
      asm volatile("ds_read_b64_tr_b16 %0,%1 offset:%c2":"=&v"(lo[ks]):"v"(vb),"i"(d0*4096+ks*1024):"memory");
      asm volatile("ds_read_b64_tr_b16 %0,%1 offset:%c2":"=&v"(hi[ks]):"v"(vb),"i"(d0*4096+ks*1024+512):"memory");}
    asm volatile("s_waitcnt lgkmcnt(0)":::"memory");SBAR();
    #define PK(k) (bf16x8){lo[k][0],lo[k][1],lo[k][2],lo[k][3],hi[k][0],hi[k][1],hi[k][2],hi[k][3]}
    o[d0]=__builtin_amdgcn_mfma_f32_32x32x16_bf16(pa0,PK(0),o[d0],0,0,0);
    o[d0]=__builtin_amdgcn_mfma_f32_32x32x16_bf16(pa1,PK(1),o[d0],0,0,0);
    o[d0]=__builtin_amdgcn_mfma_f32_32x32x16_bf16(pa2,PK(2),o[d0],0,0,0);
    o[d0]=__builtin_amdgcn_mfma_f32_32x32x16_bf16(pa3,PK(3),o[d0],0,0,0);
    #undef PK
  }
}

#ifndef ATTN_STORE16
#define ATTN_STORE16(p,v) (*(u32x4*)(p)=(v))
#endif
constexpr int V_K=0, V_V=NSLOT*SLOTB, V_WS=V_V+NSLOT*2*SLOTB, V_OST=V_WS+NW*64*4, V_LDS_BYTES=V_OST+NW*8192;
#ifndef ATTN_STORE16
#define ATTN_STORE16(p,v) (*(u32x4*)(p)=(v))
#endif
template<int THRL> __device__ __forceinline__ void attn_unit128(int b,int qcol,int vcol,int qb,const bf16*Q,const bf16*__restrict__ K,const bf16*__restrict__ V,bf16*O,char*shm,int mode,float lam,const float*subg){
  int tid_l=threadIdx.x; asm volatile("":"+v"(tid_l)); const int tid=tid_l,lane=tid&63,r32=lane&31,hi=lane>>5; const int wid=__builtin_amdgcn_readfirstlane(tid>>6);
  const long rowbase=(long)b*SEQ; const int q0=qb*QB;
  const bf16*Qw=Q+(rowbase+q0+wid*QBLK)*DM+qcol;
  const bf16*Kh=K+rowbase*DM+qcol,*Vh=V+rowbase*DM+vcol;
  const unsigned lds0=(unsigned)(uintptr_t)shm;
  float*wsf=(float*)(shm+V_WS)+wid*64;
  const bf16*ksrc=Kh+(long)lane*DM+wid*8;
  const bf16*vsrc=Vh+(long)(16*(wid&3)+(lane>>2))*DM+(wid>>2)*32+(lane&3)*8;
  const unsigned kdst=lds0+V_K+wid*1024, vdst=lds0+V_V+wid*1024;
  #define DMA_K(t,slot) glds16(ksrc+(long)(t)*KVBLK*DM,(unsigned)__builtin_amdgcn_readfirstlane(kdst+(slot)))
  #define DMA_V(t,slot) do{ glds16(vsrc+(long)(t)*KVBLK*DM,(unsigned)__builtin_amdgcn_readfirstlane(vdst+2*(slot))); glds16(vsrc+(long)(t)*KVBLK*DM+64,(unsigned)__builtin_amdgcn_readfirstlane(vdst+2*(slot)+8192)); }while(0)
  const int vb0=(int)(lds0+V_V)+((lane>>4)&1)*32+(lane&3)*8+(4*hi+((lane&15)>>2))*64;
  const char*Kbase=shm+V_K; bf16x8 kf[8];
  const lds_cptr shm3=(lds_cptr)shm; const lds_cptr kp0=shm3+V_K+hi*1024+r32*16; const lds_cptr vp0=shm3+V_V+((lane>>4)&1)*32+(lane&3)*8+(4*hi+((lane&15)>>2))*64;
  const int NT=(q0+QB)/KVBLK;
  DMA_K(0,0);DMA_V(0,0);DMA_K(1,SLOTB);
  bf16x8 qr[4];
  #pragma unroll
  for(int d0=0;d0<4;++d0)qr[d0]=*reinterpret_cast<const bf16x8*>(&Qw[(long)r32*DM+d0*16+hi*8]);
  float mhat=0.f,l_reg=0.f;f32x16 o[4];o[0]=f32x16{};o[1]=f32x16{};o[2]=f32x16{};o[3]=f32x16{};f32x16 negm=f32x16{};asm volatile("":"+v"(negm));
  const int qrel=wid*QBLK+r32;
  #define CMASK(P0,P1,t) do{int jb_=(t)-(NT-4); if(jb_>=0)cmask(P0,P1,jb_,qrel,hi);}while(0)
  bool resc=false;
  #define START(P0,P1) do{ const float rm=rowmax(P0,P1); resc=false; \
    { const float dl=rm; mhat=fadd_s(mhat,dl); \
      _Pragma("unroll") for(int r=0;r<16;++r){P0[r]=fsub_s(P0[r],dl);P1[r]=fsub_s(P1[r],dl);} \
      _Pragma("unroll") for(int r=0;r<16;++r)negm[r]=-mhat; asm volatile("":"+v"(negm)); } \
    _Pragma("unroll") for(int r=0;r<16;++r)P0[r]=__builtin_amdgcn_exp2f(P0[r]); }while(0)
  #define RESC() do{ if(resc){ asm volatile("s_waitcnt lgkmcnt(0)":::"memory"); \
      _Pragma("unroll") for(int r=0;r<16;++r){ const float f_=wsf[crow(r,hi)]; o[0][r]*=f_; o[1][r]*=f_; o[2][r]*=f_; o[3][r]*=f_; } } }while(0)
  f32x16 pA0,pA1,pB0,pB1;
  int sl_prev=0,sl_cur=0,sl_next=SLOTB;
  #define ROT() do{sl_prev=sl_cur;sl_cur=sl_next;sl_next=(sl_next==(NSLOT-1)*SLOTB)?0:sl_next+SLOTB;}while(0)
  DMA_K(2,2*SLOTB);
  WAIT_BAR(3);
  qkt(pA0,pA1,Kbase,qr,negm,r32,hi);asm volatile("s_nop 15\n\ts_nop 7":"+v"(pA0),"+v"(pA1));CMASK(pA0,pA1,0);
  START(pA0,pA1);
  _Pragma("unroll") for(int r=0;r<16;++r)pA1[r]=__builtin_amdgcn_exp2f(pA1[r]);
  WAIT_BAR(0);
  DMA_K(3,0);DMA_V(1,SLOTB);
  ROT();
  kload8(kf,kp0+sl_cur);
  WAIT_BAR(3);
  s16x4 vlo[8],vhi[8]; u32x4 pw0,pw1,pw2,pw3;
  #define PKW(P,B) cvtpk_s(P[B],P[B+1])
  #define PAF(k) __builtin_bit_cast(bf16x8,pw##k)
  #define VFR(i) (bf16x8){vlo[i][0],vlo[i][1],vlo[i][2],vlo[i][3],vhi[i][0],vhi[i][1],vhi[i][2],vhi[i][3]}
  #define PIN(x) asm volatile("":"+v"(x))
  #define MX3(a,b,c) __builtin_fmaxf(__builtin_fmaxf((a),(b)),(c))
  #define GAPA(MF,A0,A1,A2,A3,W0,W1,PW) do{ MF; sacc+=A0; sacc+=A1; sacc+=A2; sacc+=A3; PIN(sacc); W0; W1; PIN(PW); SBAR(); }while(0)
  #define EX(v) __builtin_amdgcn_exp2f(v)
  #define GAPB(MF,X,B) do{ MF; X[B]=EX(X[B]); X[B+1]=EX(X[B+1]); PIN(X); SBAR(); }while(0)
  #define VRD(i) do{ vlo[i]=vtr(vp_+(((i)>>2)*4096+((i)&3)*1024)); vhi[i]=vtr(vp_+(((i)>>2)*4096+((i)&3)*1024+512)); }while(0)
  #define VRD2(i) do{ vlo[i]=vtr(vp_+(8192+((i)>>2)*4096+((i)&3)*1024)); vhi[i]=vtr(vp_+(8192+((i)>>2)*4096+((i)&3)*1024+512)); }while(0)
  #define KRD(G,j) do{ if(G){ kload2(kf,kp0+sl_next,j); SBAR(); } }while(0)
  #define STEP(C0,C1,P0,P1,t,GK,GV,GL) do{ SBAR(); \
    const lds_cptr vp_=vp0+2*sl_prev; \
    VRD(0); SBAR(); float sacc=(P0[0]+P0[1]); \
    GAPA(C0=__builtin_amdgcn_mfma_f32_32x32x16_bf16(kf[0],qr[0],negm,0,0,0), P0[2],P0[3],P0[4],P0[5],     pw0[0]=PKW(P0,0), pw0[1]=PKW(P0,2), pw0); \
    VRD(4); SBAR(); GAPA(C1=__builtin_amdgcn_mfma_f32_32x32x16_bf16(kf[1],qr[0],negm,0,0,0), P0[6],P0[7],P0[8],P0[9],     pw0[2]=PKW(P0,4), pw0[3]=PKW(P0,6), pw0); \
    VRD(1); SBAR(); GAPA(C0=__builtin_amdgcn_mfma_f32_32x32x16_bf16(kf[2],qr[1],C0,0,0,0),   P0[10],P0[11],P0[12],P0[13], pw1[0]=PKW(P0,8), pw1[1]=PKW(P0,10), pw1); \
    VRD(5); SBAR(); GAPA(C1=__builtin_amdgcn_mfma_f32_32x32x16_bf16(kf[3],qr[1],C1,0,0,0),   P0[14],P0[15],P1[0],P1[1],   pw1[2]=PKW(P0,12),pw1[3]=PKW(P0,14), pw1); \
    VRD(2); SBAR(); GAPA(C0=__builtin_amdgcn_mfma_f32_32x32x16_bf16(kf[4],qr[2],C0,0,0,0),   P1[2],P1[3],P1[4],P1[5],     pw2[0]=PKW(P1,0), pw2[1]=PKW(P1,2), pw2); \
    VRD(6); SBAR(); GAPA(C1=__builtin_amdgcn_mfma_f32_32x32x16_bf16(kf[5],qr[2],C1,0,0,0),   P1[6],P1[7],P1[8],P1[9],     pw2[2]=PKW(P1,4), pw2[3]=PKW(P1,6), pw2); \
    VRD(3); SBAR(); GAPA(C0=__builtin_amdgcn_mfma_f32_32x32x16_bf16(kf[6],qr[3],C0,0,0,0),   P1[10],P1[11],P1[12],P1[13], pw3[0]=PKW(P1,8), pw3[1]=PKW(P1,10), pw3); \
    VRD(7); SBAR(); GAPA(C1=__builtin_amdgcn_mfma_f32_32x32x16_bf16(kf[7],qr[3],C1,0,0,0),   P1[14],P1[15],0.f,0.f,       pw3[2]=PKW(P1,12),pw3[3]=PKW(P1,14), pw3); \
    l_reg+=sacc; \
    if(GK){DMA_K((t)+3,sl_cur);} if(GV){DMA_V((t)+1,sl_next);} \
    CMASK(C0,C1,t); \
    { float a=MX3(C0[0],C0[1],C1[0]),b=MX3(C0[2],C0[3],C1[1]); a=MX3(a,C1[2],C1[3]); \
      _Pragma("unroll") for(int r=4;r<16;r+=4){a=MX3(a,C0[r],C0[r+1]);b=MX3(b,C0[r+2],C0[r+3]);a=MX3(a,C1[r],C1[r+1]);b=MX3(b,C1[r+2],C1[r+3]);} \
      float rm=__builtin_fmaxf(a,b); { auto rr=__builtin_amdgcn_permlane32_swap(__float_as_uint(rm),__float_as_uint(rm),false,false); rm=__builtin_fmaxf(__uint_as_float(rr[0]),__uint_as_float(rr[1])); } \
      resc=false; \
      if(__builtin_expect(__any(rm>(float)THRL),0)){ const float dl=__builtin_fmaxf(rm,0.f); mhat+=dl; \
        _Pragma("unroll") for(int r=0;r<16;++r){C0[r]-=dl;C1[r]-=dl;} \
        _Pragma("unroll") for(int r=0;r<16;++r)negm[r]=-mhat; asm volatile("":"+v"(negm)); \
        const float f=__builtin_amdgcn_exp2f(-dl); l_reg*=f; if(hi==0)wsf[r32]=f; resc=true; } } \
    SBAR(); \
    GAPB(o[0]=__builtin_amdgcn_mfma_f32_32x32x16_bf16(PAF(0),VFR(0),o[0],0,0,0), C0,0);  VRD2(0); SBAR(); \
    GAPB(o[1]=__builtin_amdgcn_mfma_f32_32x32x16_bf16(PAF(0),VFR(4),o[1],0,0,0), C0,2);  VRD2(4); SBAR(); \
    GAPB(o[0]=__builtin_amdgcn_mfma_f32_32x32x16_bf16(PAF(1),VFR(1),o[0],0,0,0), C0,4);  VRD2(1); SBAR(); \
    GAPB(o[1]=__builtin_amdgcn_mfma_f32_32x32x16_bf16(PAF(1),VFR(5),o[1],0,0,0), C0,6);  VRD2(5); SBAR(); \
    GAPB(o[0]=__builtin_amdgcn_mfma_f32_32x32x16_bf16(PAF(2),VFR(2),o[0],0,0,0), C0,8);  VRD2(2); SBAR(); \
    GAPB(o[1]=__builtin_amdgcn_mfma_f32_32x32x16_bf16(PAF(2),VFR(6),o[1],0,0,0), C0,10); VRD2(6); SBAR(); \
    GAPB(o[0]=__builtin_amdgcn_mfma_f32_32x32x16_bf16(PAF(3),VFR(3),o[0],0,0,0), C0,12); VRD2(3); SBAR(); \
    GAPB(o[1]=__builtin_amdgcn_mfma_f32_32x32x16_bf16(PAF(3),VFR(7),o[1],0,0,0), C0,14); VRD2(7); SBAR(); \
    GAPB(o[2]=__builtin_amdgcn_mfma_f32_32x32x16_bf16(PAF(0),VFR(0),o[2],0,0,0), C1,0); \
    GAPB(o[3]=__builtin_amdgcn_mfma_f32_32x32x16_bf16(PAF(0),VFR(4),o[3],0,0,0), C1,2); \
    KRD(GL,0); GAPB(o[2]=__builtin_amdgcn_mfma_f32_32x32x16_bf16(PAF(1),VFR(1),o[2],0,0,0), C1,4); \
    KRD(GL,1); GAPB(o[3]=__builtin_amdgcn_mfma_f32_32x32x16_bf16(PAF(1),VFR(5),o[3],0,0,0), C1,6); \
    KRD(GL,2); GAPB(o[2]=__builtin_amdgcn_mfma_f32_32x32x16_bf16(PAF(2),VFR(2),o[2],0,0,0), C1,8); \
    KRD(GL,3); GAPB(o[3]=__builtin_amdgcn_mfma_f32_32x32x16_bf16(PAF(2),VFR(6),o[3],0,0,0), C1,10); \
    GAPB(o[2]=__builtin_amdgcn_mfma_f32_32x32x16_bf16(PAF(3),VFR(3),o[2],0,0,0), C1,12); \
    GAPB(o[3]=__builtin_amdgcn_mfma_f32_32x32x16_bf16(PAF(3),VFR(7),o[3],0,0,0), C1,14); \
    }while(0)
  int t=1;
  #undef CMASK
  #define CMASK(P0,P1,t) do{}while(0)
  for(;t+5<NT;t+=2){
    STEP(pB0,pB1,pA0,pA1,t,true,true,true);     WAIT_BAR(3); RESC(); ROT();
    STEP(pA0,pA1,pB0,pB1,t+1,true,true,true);   WAIT_BAR(3); RESC(); ROT();
  }
  #undef CMASK
  #define CMASK(P0,P1,t) do{int jb_=(t)-(NT-4); if(jb_>=0)cmask(P0,P1,jb_,qrel,hi);}while(0)
  #define ENDW(tt) do{ if((tt)+3<NT){WAIT_BAR(3);} else if((tt)+2<NT){WAIT_BAR(2);} else {WAIT_BAR(0);} }while(0)
  for(;t+1<NT;t+=2){
    STEP(pB0,pB1,pA0,pA1,t,(t+3<NT),(t+1<NT),(t+1<NT));       ENDW(t);   RESC(); ROT();
    STEP(pA0,pA1,pB0,pB1,t+1,(t+4<NT),(t+2<NT),(t+2<NT));     ENDW(t+1); RESC(); ROT();
  }
  STEP(pB0,pB1,pA0,pA1,NT-1,false,false,false); RESC();
  { float sacc=pB0[0]+pB0[1]; _Pragma("unroll") for(int r=2;r<16;++r)sacc+=pB0[r]; _Pragma("unroll") for(int r=0;r<16;++r)sacc+=pB1[r]; l_reg+=sacc;
    pw0=(u32x4){PKW(pB0,0),PKW(pB0,2),PKW(pB0,4),PKW(pB0,6)};pw1=(u32x4){PKW(pB0,8),PKW(pB0,10),PKW(pB0,12),PKW(pB0,14)};pw2=(u32x4){PKW(pB1,0),PKW(pB1,2),PKW(pB1,4),PKW(pB1,6)};pw3=(u32x4){PKW(pB1,8),PKW(pB1,10),PKW(pB1,12),PKW(pB1,14)};
    SBAR(); pv(o,vb0+2*sl_cur,PAF(0),PAF(1),PAF(2),PAF(3)); pv(o+2,vb0+2*sl_cur+8192,PAF(0),PAF(1),PAF(2),PAF(3)); }
  #undef PKW
  #undef PAF
  #undef VFR
  #undef PIN
  #undef MX3
  #undef GAPA
  #undef GAPB
  #undef EX
  #undef VRD
  #undef VRD2
  #undef KRD
  #undef STEP
  #undef ENDW
  {auto rr=__builtin_amdgcn_permlane32_swap(__float_as_uint(l_reg),__float_as_uint(l_reg),false,false);l_reg=__uint_as_float(rr[0])+__uint_as_float(rr[1]);}
  if(hi==0)wsf[32+r32]=l_reg;asm volatile("s_waitcnt lgkmcnt(0)":::"memory");
  float rli[16];
  #pragma unroll
  for(int r=0;r<16;++r)rli[r]=__builtin_amdgcn_rcpf(wsf[32+crow(r,hi)]);
  bf16*Ow=O+(rowbase+q0+wid*QBLK)*DM+vcol;
  { unsigned short*stash=(unsigned short*)(shm+V_OST)+wid*4096;
    if(mode==0){
      #pragma unroll
      for(int r=0;r<16;++r){const int orow=crow(r,hi);
        #pragma unroll
        for(int q=0;q<4;++q)stash[orow*128+q*32+r32]=(unsigned short)(cvtpk_s(o[q][r]*rli[r],0.f)&0xffffu);}
    } else {
      #pragma unroll
      for(int r=0;r<16;++r){const int orow=crow(r,hi);
        #pragma unroll
        for(int q=0;q<4;++q){ const float a=__uint_as_float((unsigned)stash[orow*128+q*32+r32]<<16); const float d=a-lam*(o[q][r]*rli[r]); stash[orow*128+q*32+r32]=(unsigned short)(cvtpk_s(d,0.f)&0xffffu);} }
      asm volatile("s_waitcnt lgkmcnt(0)":::"memory");
      const int row=lane>>1,hf=lane&1; const unsigned short*rp=stash+row*128+hf*64;
      u32x4 v[8]; float ss=0.f;
      #pragma unroll
      for(int i=0;i<8;++i){ v[i]=*(const u32x4*)(rp+i*8);
        const float e0=__uint_as_float(v[i].x<<16),e1=__uint_as_float(v[i].x&0xffff0000u),e2=__uint_as_float(v[i].y<<16),e3=__uint_as_float(v[i].y&0xffff0000u),e4=__uint_as_float(v[i].z<<16),e5=__uint_as_float(v[i].z&0xffff0000u),e6=__uint_as_float(v[i].w<<16),e7=__uint_as_float(v[i].w&0xffff0000u);
        ss+=(e0*e0+e1*e1)+(e2*e2+e3*e3)+(e4*e4+e5*e5)+(e6*e6+e7*e7); }
      ss+=__shfl_xor(ss,1);
      const float rsn=__builtin_amdgcn_rsqf(ss*(1.f/128.f)+1e-5f)*0.8f;
      bf16*orow_p=Ow+(long)row*DM+hf*64;
      #pragma unroll
      for(int i=0;i<8;++i){ const float*gp=subg+hf*64+i*8; const float g0=gp[0],g1=gp[1],g2=gp[2],g3=gp[3],g4=gp[4],g5=gp[5],g6=gp[6],g7=gp[7];
        u32x4 w; w.x=cvtpk_s(__uint_as_float(v[i].x<<16)*rsn*g0,__uint_as_float(v[i].x&0xffff0000u)*rsn*g1); w.y=cvtpk_s(__uint_as_float(v[i].y<<16)*rsn*g2,__uint_as_float(v[i].y&0xffff0000u)*rsn*g3);
        w.z=cvtpk_s(__uint_as_float(v[i].z<<16)*rsn*g4,__uint_as_float(v[i].z&0xffff0000u)*rsn*g5); w.w=cvtpk_s(__uint_as_float(v[i].w<<16)*rsn*g6,__uint_as_float(v[i].w&0xffff0000u)*rsn*g7);
        ATTN_STORE16(orow_p+i*8,w); }
    } }
  asm volatile("s_waitcnt lgkmcnt(0)\n\ts_barrier":::"memory");
  #undef DMA_K
  #undef DMA_V
  #undef CMASK
  #undef START
  #undef RESC
  #undef ROT
}
constexpr int ATTN_LDS_BYTES=LDS_BYTES;
struct AttnTensors { const bf16* Q; const bf16* K; const bf16* V; bf16* Y; const float* lq1; const float* lk1; const float* lq2; const float* lk2; const float* subg; };
struct AttnUnit { int bh; int qb; };
constexpr int NBH=32;
struct StaticOrder {
  int vcu,G;
  __device__ __forceinline__ explicit StaticOrder(int grid,int block):vcu((grid%8==0)?(block%8)*(grid/8)+block/8:block),G(grid){}
  __device__ __forceinline__ bool next(int i,AttnUnit&u)const{
    if(G==256){ if(i>=4)return false; const int s=vcu&7; u.bh=vcu>>3; u.qb=(i==0)?s:(i==1)?15-s:(i==2)?16+s:31-s; return true; }
    const int L=i*G+vcu; if(L>=NBH*NQB)return false; u.bh=L/NQB; u.qb=NQB-1-(L%NQB); return true; }
};
template<class Sched,int THRL=8> __device__ __forceinline__ void attn_phase(char*lds,const AttnTensors&T,const Sched&S){
  float lam;
  { const int l_=threadIdx.x&63; float a=T.lq1[l_]*T.lk1[l_],b2=T.lq2[l_]*T.lk2[l_];
    #pragma unroll
    for(int o_=1;o_<64;o_<<=1){a+=__shfl_xor(a,o_);b2+=__shfl_xor(b2,o_);}
    lam=__expf(a)-__expf(b2)+0.2f; }
  AttnUnit u;
  for(int i=0;S.next(i,u);++i){ const int h=u.bh&7,b=u.bh>>3;
    #pragma unroll 1
    for(int map=0;map<2;++map) attn_unit128<THRL>(b,h*128+map*64,h*128,u.qb,T.Q,T.K,T.V,T.Y,lds,map,lam,T.subg); }
}
#undef SBAR
#undef WAIT_BAR
}
#define GAS __attribute__((address_space(1)))
#define LAS __attribute__((address_space(3)))
typedef unsigned short bf16;
typedef unsigned v4u __attribute__((ext_vector_type(4)));
typedef float f32x4 __attribute__((ext_vector_type(4)));
typedef float f32x16 __attribute__((ext_vector_type(16)));
typedef short bf16x8 __attribute__((ext_vector_type(8)));
using pg8::sigmoidf_fast; using pg8::gelu_tanh;
constexpr int NWAVES = 8, NTHR = 512;
constexpr int BATCH = 4, SEQ = 8192, DM = 1024, M = BATCH * SEQ, DIN = 7 * DM, DFF = 3 * DM;
constexpr float EPS = 1e-6f;
constexpr size_t MiB = 1u << 20;
constexpr size_t WS_SS = 0, WS_SS2 = 512 * 1024;
constexpr size_t WS_BAR = 768 * 1024;
constexpr size_t WS_PCNT = WS_BAR + 16 * 1024, WS_ZERO_BYTES = 16 * 1024 + 128 * 64 * 4;
constexpr size_t WS_SUM = 1 * MiB;
constexpr size_t WS_WIN = 2 * MiB, WS_WUP = 16 * MiB, WS_WDN = 28 * MiB, WS_PA = 34 * MiB, WS_PB = 36 * MiB, WS_WO = 38 * MiB, WS_WG = 40 * MiB;
constexpr size_t WS_S0 = 48 * MiB, SLOT = 64 * MiB;
constexpr size_t WS_NEED = WS_S0 + 7 * SLOT;
constexpr int RING_BYTES = 131072, LDS_BYTES = 147456, LDS_BARST = LDS_BYTES - 16;

__device__ __forceinline__ unsigned f2bf(float f) { unsigned u = __builtin_bit_cast(unsigned, f); return (u + 0x7fffu + ((u >> 16) & 1u)) >> 16; }
__device__ __forceinline__ unsigned pk2(float lo, float hi) { return f2bf(lo) | (f2bf(hi) << 16); }
__device__ __forceinline__ float bflo(unsigned w) { return __uint_as_float(w << 16); }
__device__ __forceinline__ float bfhi(unsigned w) { return __uint_as_float(w & 0xffff0000u); }
__device__ __forceinline__ float wave_sum(float v) {
#pragma unroll
    for (int o = 1; o < 64; o <<= 1) v += __shfl_xor(v, o);
    return v;
}
#define LDS_WAIT() asm volatile("s_waitcnt lgkmcnt(0)" ::: "memory")

__device__ __forceinline__ void p0_transpose_item(const float* W, int K, int N, bf16* WT, int row_off, LAS float* scr, int item, int lane, const float* kscale, bool gv_interleave = false) {
    const int nblk = N / 32, kb = item / nblk, nb = item % nblk, k0 = 64 * kb, n0 = 32 * nb;
    int no = n0; if (gv_interleave) { const int hf = N / 2, c = (n0 < hf) ? n0 : n0 - hf; no = (c >> 7) * 256 + ((n0 < hf) ? 0 : 128) + (c & 127); }
#pragma unroll
    for (int i = 0; i < 32; ++i) { const int kk = 2 * i + (lane >> 5); float w = W[(size_t)(k0 + kk) * N + n0 + (lane & 31)]; if (kscale) w *= kscale[k0 + kk]; scr[kk * 33 + (lane & 31)] = w; }
    LDS_WAIT(); asm volatile("" ::: "memory");
    const int c = lane & 7;
#pragma unroll
    for (int j = 0; j < 4; ++j) { const int n = (lane >> 3) + 8 * j; const LAS float* s = scr + (8 * c) * 33 + n;
        v4u o; o.x = pk2(s[0 * 33], s[1 * 33]); o.y = pk2(s[2 * 33], s[3 * 33]); o.z = pk2(s[4 * 33], s[5 * 33]); o.w = pk2(s[6 * 33], s[7 * 33]);
        *(v4u*)(WT + (size_t)(row_off + no + n) * K + k0 + 8 * c) = o; }
    LDS_WAIT(); asm volatile("" ::: "memory");
}

#define RLX_AGENT __ATOMIC_RELAXED, __HIP_MEMORY_SCOPE_AGENT
#define XB_TMO      128
#define XB_XCNT(j)  (256  + 64 * (j))
#define XB_XSUB(j)  (1280 + 64 * (j))
#define XB_XGEN(j)  (2304 + 64 * (j))
#define XB_TOP      3328
#define XB_TOPGEN   3392
#define XCD_BAR_WORDS 3456
#define XB_SPIN_CAP (1u << 18)

__device__ __forceinline__ unsigned xb_ld(unsigned* p)              { return __hip_atomic_load(p, __ATOMIC_RELAXED, __HIP_MEMORY_SCOPE_AGENT); }
__device__ __forceinline__ unsigned xb_add(unsigned* p, unsigned v) { return __hip_atomic_fetch_add(p, v, __ATOMIC_RELAXED, __HIP_MEMORY_SCOPE_AGENT); }
__device__ __forceinline__ unsigned xb_xcc_id() { return (unsigned)__builtin_amdgcn_s_getreg((3 << 11) | 20) & 0xFu; }
#define XB_SPIN(cond, bar) do { unsigned _sp = 0; while (cond) { __builtin_amdgcn_s_sleep(1); \
    if ((++_sp & 255u) == 0u) { if (xb_ld(&(bar)[XB_TMO])) break; if (_sp > XB_SPIN_CAP) { atomicAdd(&(bar)[XB_TMO], 1u); break; } } } } while (0)

struct XcdBarrier {
    unsigned* bar; unsigned x;
    volatile LAS unsigned* st;
};

__device__ __forceinline__ XcdBarrier xcd_barrier_post(unsigned* bar, volatile LAS unsigned* st) {
    XcdBarrier b; b.bar = bar; b.x = xb_xcc_id(); b.st = st;
    if (threadIdx.x == 0) (void)xb_add(&bar[XB_XCNT(b.x)], 1u);
    return b;
}
__device__ __forceinline__ void xcd_barrier_complete(unsigned* bar, unsigned x, unsigned& nloc, unsigned& nx) {
    const unsigned G = gridDim.x * gridDim.y * gridDim.z;
    unsigned sum, cnt, mine, sp = 0u;
    for (;;) {
        sum = 0u; cnt = 0u; mine = 0u;
#pragma unroll
        for (unsigned j = 0; j < 16; ++j) { const unsigned c = xb_ld(&bar[XB_XCNT(j)]); sum += c; cnt += (c > 0u) ? 1u : 0u; mine = (j == x) ? c : mine; }
        if (sum == G) break;
        __builtin_amdgcn_s_sleep(1);
        if ((++sp & 255u) == 0u) { if (xb_ld(&bar[XB_TMO])) break; if (sp > XB_SPIN_CAP) { atomicAdd(&bar[XB_TMO], 1u); break; } }
    }
    nloc = mine > 0u ? mine : 1u; nx = cnt > 0u ? cnt : 1u;
}

__device__ __forceinline__ void xcd_barrier(const XcdBarrier& b) {
    asm volatile("s_waitcnt vmcnt(0)" ::: "memory");
    __syncthreads();
    if (threadIdx.x == 0) {
        unsigned* bar = b.bar;
        __builtin_amdgcn_s_waitcnt(0);
        unsigned nloc = b.st[0], nx = b.st[1];
        if (nloc == 0u) { xcd_barrier_complete(bar, b.x, nloc, nx); b.st[0] = nloc; b.st[1] = nx; }
        const unsigned old = xb_add(&bar[XB_XSUB(b.x)], 1u);
        const unsigned gen = old / nloc;
        if (old + 1u == (gen + 1u) * nloc) {
            __builtin_amdgcn_fence(__ATOMIC_RELEASE, "agent");
            asm volatile("s_waitcnt vmcnt(0)" ::: "memory");
            const unsigned og = xb_add(&bar[XB_TOP], 1u);
            const unsigned tg = og / nx;
            if (og + 1u == (tg + 1u) * nx) xb_add(&bar[XB_TOPGEN], 1u);
            else XB_SPIN(xb_ld(&bar[XB_TOPGEN]) == tg, bar);
            __builtin_amdgcn_fence(__ATOMIC_ACQUIRE, "agent");
            xb_add(&bar[XB_XGEN(b.x)], 1u);
            asm volatile("s_waitcnt vmcnt(0)" ::: "memory");
        } else {
            XB_SPIN(xb_ld(&bar[XB_XGEN(b.x)]) == gen, bar);
            __builtin_amdgcn_fence(__ATOMIC_ACQUIRE, "agent");
            asm volatile("s_waitcnt vmcnt(0)" ::: "memory");
        }
    }
    __syncthreads();
}

typedef float f32x2v __attribute__((ext_vector_type(2)));
constexpr int XC_PITCH = 264;
__device__ __forceinline__ int crow16(int r, int hi) { return (r & 3) + 8 * (r >> 2) + 4 * hi; }
template <int MODE>
__device__ __forceinline__ void rnn_unit(LAS unsigned char* lds, int tile, int cpair, const bf16* XR, const bf16* GR, bf16* YR, const bf16* WG, float* SUMM,
                                         const float* conv_w, const float* conv_b, const float* ba, const float* bx, const float* lam) {
    int tid_l = threadIdx.x; asm volatile("" : "+v"(tid_l));
    const int tid = tid_l, lane = tid & 63, w = __builtin_amdgcn_readfirstlane(tid >> 6), j = lane & 31, hi = lane >> 5;
    const int tb = tile & 31;
    const size_t R0 = (size_t)tile * 256;
    const int c0 = cpair * 256;
    LAS bf16* XC = (LAS bf16*)lds;
    {
        const int chunk = tid & 31, rg = tid >> 5, cc = c0 + chunk * 8;
        float wk[4][8], bb[8];
#pragma unroll
        for (int k = 0; k < 4; ++k) { const f32x4 a = *(const f32x4*)(conv_w + k * 1024 + cc), b = *(const f32x4*)(conv_w + k * 1024 + cc + 4);
            wk[k][0] = a[0]; wk[k][1] = a[1]; wk[k][2] = a[2]; wk[k][3] = a[3]; wk[k][4] = b[0]; wk[k][5] = b[1]; wk[k][6] = b[2]; wk[k][7] = b[3]; }
        { const f32x4 a = *(const f32x4*)(conv_b + cc), b = *(const f32x4*)(conv_b + cc + 4); bb[0] = a[0]; bb[1] = a[1]; bb[2] = a[2]; bb[3] = a[3]; bb[4] = b[0]; bb[5] = b[1]; bb[6] = b[2]; bb[7] = b[3]; }
        float win[3][8];
        const int r0 = rg * 16;
#pragma unroll
        for (int q = 0; q < 3; ++q) { const int r = r0 - 3 + q; v4u v = (v4u){0u, 0u, 0u, 0u};
            if (r >= 0 || tb > 0) v = *(const v4u*)(XR + (size_t)((long)R0 + r) * 1024 + cc);
            win[q][0] = bflo(v.x); win[q][1] = bfhi(v.x); win[q][2] = bflo(v.y); win[q][3] = bfhi(v.y); win[q][4] = bflo(v.z); win[q][5] = bfhi(v.z); win[q][6] = bflo(v.w); win[q][7] = bfhi(v.w); }
#pragma unroll
        for (int i = 0; i < 16; ++i) { const int r = r0 + i; const v4u v = *(const v4u*)(XR + (R0 + r) * 1024 + cc);
            float cur[8] = {bflo(v.x), bfhi(v.x), bflo(v.y), bfhi(v.y), bflo(v.z), bfhi(v.z), bflo(v.w), bfhi(v.w)};
            float o[8];
#pragma unroll
            for (int e = 0; e < 8; ++e) o[e] = bb[e] + wk[0][e] * win[0][e] + wk[1][e] * win[1][e] + wk[2][e] * win[2][e] + wk[3][e] * cur[e];
            v4u ov; ov.x = pk2(o[0], o[1]); ov.y = pk2(o[2], o[3]); ov.z = pk2(o[4], o[5]); ov.w = pk2(o[6], o[7]);
            *(LAS v4u*)(XC + r * XC_PITCH + chunk * 8) = ov;
#pragma unroll
            for (int e = 0; e < 8; ++e) { win[0][e] = win[1][e]; win[1][e] = win[2][e]; win[2][e] = cur[e]; } }
    }
    __syncthreads();
    const int ch = c0 + w * 32 + j;
    const int nblk = ch >> 7, jb = ch & 127;
    bf16x8 BR[8], BI[8];
#pragma unroll
    for (int ks = 0; ks < 8; ++ks) { BR[ks] = *(const bf16x8*)(WG + ((size_t)nblk * 256 + jb) * 128 + ks * 16 + hi * 8); BI[ks] = *(const bf16x8*)(WG + ((size_t)nblk * 256 + 128 + jb) * 128 + ks * 16 + hi * 8); }
    const float bav = ba[ch], bxv = bx[ch];
    const float lm = lam[ch];
    const float sp = (lm > 15.f) ? __expf(-lm) : log1pf(__expf(-lm));
    const float c8l2 = -8.0f * 1.4426950408889634f * sp;
    float h = 0.f, Atot = 1.f;
    if (MODE == 1) { const float* sb = SUMM + (size_t)(tile - tb) * 2048 + ch;
        for (int q0 = 0; q0 < tb; q0 += 8) { float A_[8], B_[8];
#pragma unroll
            for (int e = 0; e < 8; ++e) { const int q = (q0 + e < tb) ? q0 + e : tb - 1; A_[e] = sb[(size_t)q * 2048]; B_[e] = sb[(size_t)q * 2048 + 1024]; }
#pragma unroll
            for (int e = 0; e < 8; ++e) if (q0 + e < tb) h = A_[e] * h + B_[e]; } }
    const int kcol = (w >> 2) * 128;
    const bf16* grb = GR + (R0 + 4 * hi) * 1024 + ch; bf16* yrb = YR + (R0 + 4 * hi) * 1024 + ch;
    const float NL = -1.4426950408889634f; const f32x2v nbr = (f32x2v){NL * bav, NL * bav}, nbi = (f32x2v){NL * bxv, NL * bxv};
#pragma unroll 1
    for (int t32 = 0; t32 < 8; ++t32) {
        f32x16 aR, aI;
        unsigned short grv[16];
        if (MODE == 1) {
#pragma unroll
            for (int r = 0; r < 16; ++r) grv[r] = grb[(size_t)t32 * 32768 + ((r & 3) + 8 * (r >> 2)) * 1024]; }
#pragma unroll
        for (int r = 0; r < 16; ++r) { aR[r] = 0.f; aI[r] = 0.f; }
        const LAS bf16* arow = XC + (t32 * 32 + j) * XC_PITCH + kcol + hi * 8;
#pragma unroll
        for (int ks = 0; ks < 8; ++ks) { const bf16x8 a = *(const LAS bf16x8*)(arow + ks * 16);
            aR = __builtin_amdgcn_mfma_f32_32x32x16_bf16(a, BR[ks], aR, 0, 0, 0); aI = __builtin_amdgcn_mfma_f32_32x32x16_bf16(a, BI[ks], aI, 0, 0, 0); }
        float av[16], bv[16];
        const LAS bf16* xcol = XC + (t32 * 32 + 4 * hi) * XC_PITCH + w * 32 + j;
#pragma unroll
        for (int r = 0; r < 16; r += 2) { const int ro = (r & 3) + 8 * (r >> 2);
            const f32x2v x2 = (f32x2v){__uint_as_float((unsigned)xcol[ro * XC_PITCH] << 16), __uint_as_float((unsigned)xcol[(ro + 1) * XC_PITCH] << 16)};
            f32x2v er = (f32x2v){aR[r], aR[r + 1]} * NL + nbr, ei = (f32x2v){aI[r], aI[r + 1]} * NL + nbi;
            er.x = __builtin_amdgcn_exp2f(er.x); er.y = __builtin_amdgcn_exp2f(er.y); ei.x = __builtin_amdgcn_exp2f(ei.x); ei.y = __builtin_amdgcn_exp2f(ei.y);
            er = er + 1.0f; ei = ei + 1.0f;
            f32x2v rg; rg.x = __builtin_amdgcn_rcpf(er.x); rg.y = __builtin_amdgcn_rcpf(er.y);
            f32x2v a2 = rg * c8l2; a2.x = __builtin_amdgcn_exp2f(a2.x); a2.y = __builtin_amdgcn_exp2f(a2.y);
            f32x2v om = 1.0f - a2 * a2; om.x = fmaxf(om.x, 1e-30f); om.y = fmaxf(om.y, 1e-30f);
            f32x2v q2 = om * ei * ei; q2.x = __builtin_amdgcn_rsqf(q2.x); q2.y = __builtin_amdgcn_rsqf(q2.y);
            const f32x2v b2 = om * q2 * x2;
            av[r] = a2.x; av[r + 1] = a2.y; bv[r] = b2.x; bv[r + 1] = b2.y; }
        float Ag[4], Bg[4], pA[4], pB[4], hs[4];
#pragma unroll
        for (int g = 0; g < 4; ++g) { float A = av[4 * g], B = bv[4 * g];
#pragma unroll
            for (int e = 1; e < 4; ++e) { B = av[4 * g + e] * B + bv[4 * g + e]; A *= av[4 * g + e]; }
            Ag[g] = A; Bg[g] = B; pA[g] = __shfl_xor(A, 32); pB[g] = __shfl_xor(B, 32); }
        float hrun = h;
#pragma unroll
        for (int g = 0; g < 4; ++g) { const float loA = hi ? pA[g] : Ag[g], loB = hi ? pB[g] : Bg[g], hiA = hi ? Ag[g] : pA[g], hiB = hi ? Bg[g] : pB[g];
            const float hmid = loA * hrun + loB; hs[g] = hi ? hmid : hrun; hrun = hiA * hmid + hiB; if (MODE == 0) Atot *= loA * hiA; }
        h = hrun;
        if (MODE == 1) {
#pragma unroll
            for (int g = 0; g < 4; ++g) { float hh = hs[g]; float yv[4];
#pragma unroll
                for (int e = 0; e < 4; ++e) { const int r = 4 * g + e; hh = av[r] * hh + bv[r]; yv[e] = hh * gelu_tanh(__uint_as_float((unsigned)grv[r] << 16)); }
                const unsigned p01 = pg8::cvt_pk_bf16(yv[0], yv[1]), p23 = pg8::cvt_pk_bf16(yv[2], yv[3]);
                bf16* yp = yrb + (size_t)t32 * 32768 + (size_t)(8 * g) * 1024;
                yp[0] = (bf16)(p01 & 0xffffu); yp[1024] = (bf16)(p01 >> 16); yp[2048] = (bf16)(p23 & 0xffffu); yp[3072] = (bf16)(p23 >> 16); }
        }
    }
    if (MODE == 0 && hi == 0) { SUMM[(size_t)tile * 2048 + ch] = Atot; SUMM[(size_t)tile * 2048 + 1024 + ch] = h; }
    __syncthreads();
}

struct Args { const float* in[24]; float* out; unsigned char* ws; };
__global__ void __launch_bounds__(NTHR, 2) fwd_megakernel(Args args) {
    extern __shared__ __attribute__((aligned(16))) unsigned char lds[];
    cg::grid_group grid = cg::this_grid();
    LAS unsigned char* L = (LAS unsigned char*)lds;
    if (threadIdx.x < 4) ((LAS unsigned*)(L + LDS_BARST))[threadIdx.x] = 0u;
    __syncthreads();
    const int G = gridDim.x, bx = blockIdx.x;
    const int vcu = (G % 8 == 0) ? (bx % 8) * (G / 8) + bx / 8 : bx;
    const int NGW = G * NWAVES;
#define PHASE_IDS() int tid_l = threadIdx.x; asm volatile("" : "+v"(tid_l)); const int tid = tid_l, lane = tid & 63, wave = __builtin_amdgcn_readfirstlane(tid >> 6), gw = vcu * NWAVES + wave; (void)lane; (void)gw
    unsigned char* ws = args.ws;
    const XcdBarrier xbar = xcd_barrier_post((unsigned*)(ws + WS_BAR), (volatile LAS unsigned*)(L + LDS_BARST));
    const float* x = args.in[0];
    float* out = args.out;
    float* SS = (float*)(ws + WS_SS); float* SS2 = (float*)(ws + WS_SS2); float* SUMM = (float*)(ws + WS_SUM);
    bf16 *WinT = (bf16*)(ws + WS_WIN), *WupT = (bf16*)(ws + WS_WUP), *WdnT = (bf16*)(ws + WS_WDN), *PAT = (bf16*)(ws + WS_PA), *PBT = (bf16*)(ws + WS_PB), *WoT = (bf16*)(ws + WS_WO), *WG = (bf16*)(ws + WS_WG);
    bf16* S0 = (bf16*)(ws + WS_S0);
#define SLOTP(i) ((bf16*)(ws + WS_S0 + (size_t)(i) * SLOT))
    bf16 *XR = SLOTP(0), *GRb = SLOTP(1), *Qb = SLOTP(2), *Kb = SLOTP(3), *Vb = SLOTP(4), *GRNN = SLOTP(5), *GATT = SLOTP(6);
    bf16 *XN = (bf16*)out, *YATT = (bf16*)out + (size_t)M * DM;
    bf16 *YRNN = SLOTP(2); bf16* MERGED = SLOTP(0);
    bf16 *X1B = SLOTP(6), *X2B = SLOTP(5), *ACT = SLOTP(0), *SG = SLOTP(3), *SV = SLOTP(4);

    {
        PHASE_IDS();
        LAS float* scr = (LAS float*)(L + wave * 16384);
        constexpr int I_IN = 16 * (DIN / 32), I_UP = 16 * (2 * DFF / 32), I_DN = (DFF / 64) * 32, I_SQ = 16 * 32;
        constexpr int NITEMS = I_IN + I_UP + I_DN + 3 * I_SQ;
        struct TItem { const float* W; bf16* WT; const float* ks; int K, N, k0, n0, no; };
        auto decode = [&](int it) -> TItem {
            TItem t; int r = it; bool gvi = false;
            if (r < I_IN) { t.W = args.in[2]; t.K = DM; t.N = DIN; t.WT = WinT; t.ks = nullptr; }
            else if ((r -= I_IN) < I_UP) { t.W = args.in[19]; t.K = DM; t.N = 2 * DFF; t.WT = WupT; t.ks = args.in[18]; gvi = true; }
            else if ((r -= I_UP) < I_DN) { t.W = args.in[22]; t.K = DFF; t.N = DM; t.WT = WdnT; t.ks = nullptr; }
            else if ((r -= I_DN) < I_SQ) { t.W = args.in[15]; t.K = DM; t.N = DM; t.WT = PAT; t.ks = nullptr; }
            else if ((r -= I_SQ) < I_SQ) { t.W = args.in[16]; t.K = DM; t.N = DM; t.WT = PBT; t.ks = nullptr; }
            else { r -= I_SQ; t.W = args.in[17]; t.K = DM; t.N = DM; t.WT = WoT; t.ks = nullptr; }
            const int nblk = t.N / 32, kb = r / nblk, nb = r % nblk; t.k0 = 64 * kb; t.n0 = 32 * nb; t.no = t.n0;
            if (gvi) { const int hf = t.N / 2, c = (t.n0 < hf) ? t.n0 : t.n0 - hf; t.no = (c >> 7) * 256 + ((t.n0 < hf) ? 0 : 128) + (c & 127); }
            return t; };
        float wv[32], wn[32];
        int it = gw;
        TItem cur = decode(it < NITEMS ? it : 0);
        if (it < NITEMS) {
#pragma unroll
            for (int i = 0; i < 32; ++i) wv[i] = cur.W[(size_t)(cur.k0 + 2 * i + (lane >> 5)) * cur.N + cur.n0 + (lane & 31)]; }
        while (it < NITEMS) {
            const int itn = it + NGW; const bool hn = itn < NITEMS;
            const TItem nxt = decode(hn ? itn : it);
            if (hn) {
#pragma unroll
                for (int i = 0; i < 32; ++i) wn[i] = nxt.W[(size_t)(nxt.k0 + 2 * i + (lane >> 5)) * nxt.N + nxt.n0 + (lane & 31)]; }
#pragma unroll
            for (int i = 0; i < 32; ++i) { const int kk = 2 * i + (lane >> 5); float w = wv[i]; if (cur.ks) w *= cur.ks[cur.k0 + kk]; scr[kk * 33 + (lane & 31)] = w; }
            LDS_WAIT(); asm volatile("" ::: "memory");
            { const int c = lane & 7;
#pragma unroll
              for (int j = 0; j < 4; ++j) { const int n = (lane >> 3) + 8 * j; const LAS float* sp = scr + (8 * c) * 33 + n;
                v4u o; o.x = pk2(sp[0 * 33], sp[1 * 33]); o.y = pk2(sp[2 * 33], sp[3 * 33]); o.z = pk2(sp[4 * 33], sp[5 * 33]); o.w = pk2(sp[6 * 33], sp[7 * 33]);
                *(v4u*)(cur.WT + (size_t)(cur.no + n) * cur.K + cur.k0 + 8 * c) = o; } }
            LDS_WAIT(); asm volatile("" ::: "memory");
            if (hn) {
#pragma unroll
                for (int i = 0; i < 32; ++i) wv[i] = wn[i]; }
            cur = nxt; it = itn;
        }
        for (int e = bx * NTHR + tid; e < 8 * 256 * 128; e += G * NTHR) { const int i = e & 127, jj = (e >> 7) & 127, g = (e >> 14) & 1, n = e >> 15;
            WG[e] = (bf16)f2bf((g ? args.in[7] : args.in[5])[(size_t)n * 16384 + i * 128 + jj]); }
        for (int e = bx * NTHR + tid; e < M; e += G * NTHR) { SS[e] = 0.f; SS2[e] = 0.f; }
        const float* g1 = args.in[1];
        f32x4 gv[4];
#pragma unroll
        for (int q = 0; q < 4; ++q) gv[q] = *((const f32x4*)g1 + lane + 64 * q);
        {
            f32x4 v[4], v2[4], nv[4], nv2[4];
            int m = gw;
            if (m < M) { const f32x4* xr = (const f32x4*)(x + (size_t)m * DM) + lane; const f32x4* xr2 = (const f32x4*)(x + (size_t)((m + NGW < M) ? m + NGW : m) * DM) + lane;
#pragma unroll
                for (int q = 0; q < 4; ++q) { v[q] = xr[64 * q]; v2[q] = xr2[64 * q]; } }
            while (m < M) {
                const int m2 = m + NGW; const bool has2 = m2 < M; const int mn = m + 2 * NGW; const bool hn = mn < M;
                if (hn) { const f32x4* xr = (const f32x4*)(x + (size_t)mn * DM) + lane; const f32x4* xr2 = (const f32x4*)(x + (size_t)((mn + NGW < M) ? mn + NGW : mn) * DM) + lane;
#pragma unroll
                    for (int q = 0; q < 4; ++q) { nv[q] = xr[64 * q]; nv2[q] = xr2[64 * q]; } }
                float s = 0.f, s2 = 0.f;
#pragma unroll
                for (int q = 0; q < 4; ++q) { s += (v[q].x * v[q].x + v[q].y * v[q].y) + (v[q].z * v[q].z + v[q].w * v[q].w); s2 += (v2[q].x * v2[q].x + v2[q].y * v2[q].y) + (v2[q].z * v2[q].z + v2[q].w * v2[q].w); }
                const float rs = __builtin_amdgcn_rsqf(wave_sum(s) * (1.f / DM) + EPS), rs2 = __builtin_amdgcn_rsqf(wave_sum(s2) * (1.f / DM) + EPS);
                unsigned long long* o8 = (unsigned long long*)(XN + (size_t)m * DM) + lane;
#pragma unroll
                for (int q = 0; q < 4; ++q) o8[64 * q] = (unsigned long long)pk2(v[q].x * rs * gv[q].x, v[q].y * rs * gv[q].y) | ((unsigned long long)pk2(v[q].z * rs * gv[q].z, v[q].w * rs * gv[q].w) << 32);
                if (has2) { unsigned long long* p8 = (unsigned long long*)(XN + (size_t)m2 * DM) + lane;
#pragma unroll
                    for (int q = 0; q < 4; ++q) p8[64 * q] = (unsigned long long)pk2(v2[q].x * rs2 * gv[q].x, v2[q].y * rs2 * gv[q].y) | ((unsigned long long)pk2(v2[q].z * rs2 * gv[q].z, v2[q].w * rs2 * gv[q].w) << 32); }
                if (hn) {
#pragma unroll
                    for (int q = 0; q < 4; ++q) { v[q] = nv[q]; v2[q] = nv2[q]; } }
                m = mn;
            }
        }
    }
    xcd_barrier(xbar);
    if (G == 0x7fffffff) grid.sync();
    {
        pg8::Gemm g{XN, WinT, M, DIN, DM}; pg8::StaticOrder S; S.init(M, DIN, G, bx);
        pg8::Epi<0> E{S0, nullptr, nullptr, nullptr, nullptr, DM, DM, (size_t)SLOT / 2, 2, attn_body::C2};
        pg8::gemm_phase<pg8::Epi<0>, pg8::StaticOrder, true, true>(L, g, S, E);
    }
    xcd_barrier(xbar);
    {
        const attn_body::AttnTensors AT{(const attn_body::bf16*)Qb, (const attn_body::bf16*)Kb, (const attn_body::bf16*)Vb, (attn_body::bf16*)YATT, args.in[10], args.in[11], args.in[12], args.in[13], args.in[14]};
        const attn_body::StaticOrder S(G, bx);
        attn_body::attn_phase<attn_body::StaticOrder>((char*)lds, AT, S);
        __syncthreads();
        for (int u = vcu; u < 512; u += G) rnn_unit<0>(L, u >> 2, u & 3, XR, GRb, YRNN, WG, SUMM, args.in[3], args.in[4], args.in[6], args.in[8], args.in[9]);
    }
    xcd_barrier(xbar);
    {
        PHASE_IDS();
        for (int u = vcu; u < 512; u += G) rnn_unit<1>(L, u >> 2, u & 3, XR, GRb, YRNN, WG, SUMM, args.in[3], args.in[4], args.in[6], args.in[8], args.in[9]);
    }
    xcd_barrier(xbar);
    {
        pg8::StaticOrder S; S.init(M, DM, G, bx);
        pg8::Gemm g{YRNN, PAT, M, DM, DM, YATT, PBT}; pg8::EpiMerge E{MERGED, GRNN, GATT};
        pg8::gemm_phase<pg8::EpiMerge, pg8::StaticOrder, true, true, true>(L, g, S, E);
    }
    xcd_barrier(xbar);
    {
        pg8::Gemm g{MERGED, WoT, M, DM, DM}; pg8::StaticOrder S; S.init(M, DM, G, bx);
        pg8::EpiRes3 E{X1B, x, SS};
        pg8::gemm_phase<pg8::EpiRes3, pg8::StaticOrder, true, true>(L, g, S, E);
    }
    xcd_barrier(xbar);
    {
        pg8::Gemm g{X1B, WupT, M, 2 * DFF, DM}; pg8::StaticOrder S; S.init(M, 2 * DFF, G, bx);
        pg8::EpiAct E{ACT, SS, args.in[20], args.in[21], SG, SV};
        pg8::gemm_phase<pg8::EpiAct, pg8::StaticOrder, true, true>(L, g, S, E);
    }
    xcd_barrier(xbar);
    {
        PHASE_IDS();
        const float* cw = args.in[20]; const float* cb = args.in[21];
        for (int it = bx * NTHR + tid; it < (M / 64) * 384; it += G * NTHR) {
            const int chunk = it % 384, strip = it / 384, cc = chunk * 8;
            const bool first = (strip % (SEQ / 64)) == 0;
            v4u p2 = (v4u){0u, 0u, 0u, 0u}, p1 = p2;
            if (!first) { p2 = *(const v4u*)(SG + ((size_t)(strip - 1) * 4 + 0) * DFF + cc); p1 = *(const v4u*)(SG + ((size_t)(strip - 1) * 4 + 1) * DFF + cc); }
            const v4u g0 = *(const v4u*)(SG + ((size_t)strip * 4 + 2) * DFF + cc), g1 = *(const v4u*)(SG + ((size_t)strip * 4 + 3) * DFF + cc);
            const v4u v0 = *(const v4u*)(SV + ((size_t)strip * 2 + 0) * DFF + cc), v1 = *(const v4u*)(SV + ((size_t)strip * 2 + 1) * DFF + cc);
            const unsigned P2[4] = {p2.x, p2.y, p2.z, p2.w}, P1[4] = {p1.x, p1.y, p1.z, p1.w}, G0[4] = {g0.x, g0.y, g0.z, g0.w}, G1[4] = {g1.x, g1.y, g1.z, g1.w}, V0[4] = {v0.x, v0.y, v0.z, v0.w}, V1[4] = {v1.x, v1.y, v1.z, v1.w};
            unsigned o0[4], o1[4];
#pragma unroll
            for (int q = 0; q < 4; ++q) {
                float r0[2], r1[2];
#pragma unroll
                for (int hh = 0; hh < 2; ++hh) { const int c = cc + 2 * q + hh;
                    const float w0 = cw[c], w1 = cw[DFF + c], w2 = cw[2 * DFF + c], b = cb[c];
                    const float a2 = hh ? bfhi(P2[q]) : bflo(P2[q]), a1 = hh ? bfhi(P1[q]) : bflo(P1[q]), x0 = hh ? bfhi(G0[q]) : bflo(G0[q]), x1 = hh ? bfhi(G1[q]) : bflo(G1[q]);
                    const float u0 = hh ? bfhi(V0[q]) : bflo(V0[q]), u1 = hh ? bfhi(V1[q]) : bflo(V1[q]);
                    r0[hh] = gelu_tanh(b + w0 * a2 + w1 * a1 + w2 * x0) * u0;
                    r1[hh] = gelu_tanh(b + w0 * a1 + w1 * x0 + w2 * x1) * u1; }
                o0[q] = pk2(r0[0], r0[1]); o1[q] = pk2(r1[0], r1[1]); }
            *(v4u*)(ACT + ((size_t)strip * 64 + 0) * DFF + cc) = (v4u){o0[0], o0[1], o0[2], o0[3]};
            *(v4u*)(ACT + ((size_t)strip * 64 + 1) * DFF + cc) = (v4u){o1[0], o1[1], o1[2], o1[3]};
        }
    }
    xcd_barrier(xbar);
    const bool fuse9 = (G == 256);
    if (fuse9) {
        pg8::Gemm g{ACT, WdnT, M, DM, DFF}; pg8::StaticOrder S; S.init(M, DM, G, bx);
        pg8::EpiRes5F E{out, X1B, SS2, args.in[23], (unsigned*)(ws + WS_PCNT)};
        pg8::gemm_phase<pg8::EpiRes5F, pg8::StaticOrder, true, true>(L, g, S, E);
    } else {
        pg8::Gemm g{ACT, WdnT, M, DM, DFF}; pg8::StaticOrder S; S.init(M, DM, G, bx);
        pg8::EpiRes5 E{X2B, X1B, SS2};
        pg8::gemm_phase<pg8::EpiRes5, pg8::StaticOrder, true, true>(L, g, S, E);
    }
    if (!fuse9) xcd_barrier(xbar);
    if (!fuse9) {
        PHASE_IDS();
        const float* gf = args.in[23];
        f32x4 gv[2][2];
#pragma unroll
        for (int q = 0; q < 2; ++q) { gv[q][0] = *(const f32x4*)(gf + q * 512 + lane * 8); gv[q][1] = *(const f32x4*)(gf + q * 512 + lane * 8 + 4); }
        {
            v4u xv[4][2], nx[4][2]; float ssv[4], nss[4];
            int m0 = gw * 4;
            if (m0 < M) {
#pragma unroll
                for (int k = 0; k < 4; ++k) { const bf16* xr = X2B + (size_t)(m0 + k) * DM + lane * 8; xv[k][0] = *(const v4u*)xr; xv[k][1] = *(const v4u*)(xr + 512); ssv[k] = SS2[m0 + k]; } }
            while (m0 < M) {
                const int mn = m0 + NGW * 4; const bool hn = mn < M;
                if (hn) {
#pragma unroll
                    for (int k = 0; k < 4; ++k) { const bf16* xr = X2B + (size_t)(mn + k) * DM + lane * 8; nx[k][0] = *(const v4u*)xr; nx[k][1] = *(const v4u*)(xr + 512); nss[k] = SS2[mn + k]; } }
#pragma unroll
                for (int k = 0; k < 4; ++k) { float* orow = out + (size_t)(m0 + k) * DM + lane * 8; const float rs = __builtin_amdgcn_rsqf(ssv[k] * (1.f / DM) + EPS);
#pragma unroll
                    for (int q = 0; q < 2; ++q) { const v4u w = xv[k][q];
                        f32x4 a = (f32x4){bflo(w.x), bfhi(w.x), bflo(w.y), bfhi(w.y)}, b = (f32x4){bflo(w.z), bfhi(w.z), bflo(w.w), bfhi(w.w)};
                        *(f32x4*)(orow + q * 512) = a * rs * gv[q][0]; *(f32x4*)(orow + q * 512 + 4) = b * rs * gv[q][1]; } }
                if (hn) {
#pragma unroll
                    for (int k = 0; k < 4; ++k) { xv[k][0] = nx[k][0]; xv[k][1] = nx[k][1]; ssv[k] = nss[k]; } }
                m0 = mn;
            }
        }
    }
}

extern "C" void kernel_launch(void* const* d_in, const int* in_sizes, int n_in, void* d_out, int out_size, void* d_ws, size_t ws_size, hipStream_t stream) {
    static int grid = 0;
    if (grid == 0) {
        if (n_in != 24 || in_sizes[0] != M * DM || out_size != M * DM || ws_size < WS_NEED) { fprintf(stderr, "kernel_launch: unexpected shapes / workspace (n_in %d, in0 %d, out %d, ws %zu, need %zu)\n", n_in, n_in > 0 ? in_sizes[0] : -1, out_size, ws_size, (size_t)WS_NEED); grid = -1; return; }
        int dev = 0, cus = 0, per_cu = 0;
        hipGetDevice(&dev); hipDeviceGetAttribute(&cus, hipDeviceAttributeMultiprocessorCount, dev);
        if (hipFuncSetAttribute((const void*)fwd_megakernel, hipFuncAttributeMaxDynamicSharedMemorySize, LDS_BYTES) != hipSuccess) { fprintf(stderr, "kernel_launch: hipFuncSetAttribute failed\n"); grid = -1; return; }
        if (hipOccupancyMaxActiveBlocksPerMultiprocessor(&per_cu, (const void*)fwd_megakernel, NTHR, LDS_BYTES) != hipSuccess || per_cu < 1) { fprintf(stderr, "kernel_launch: occupancy query gave %d\n", per_cu); per_cu = 1; (void)hipGetLastError(); }
        grid = cus * 1;
        if (per_cu < 1) grid = -1;
    }
    if (grid < 0) return;
    Args a{};
    for (int i = 0; i < 24; ++i) a.in[i] = (const float*)d_in[i];
    a.out = (float*)d_out; a.ws = (unsigned char*)d_ws;
    if (hipMemsetAsync((char*)d_ws + WS_BAR, 0, WS_ZERO_BYTES, stream) != hipSuccess) { fprintf(stderr, "kernel_launch: memset of the barrier words failed\n"); return; }
    void* kargs[] = {&a};
    hipError_t e = hipLaunchCooperativeKernel((const void*)fwd_megakernel, dim3(grid), dim3(NTHR), kargs, LDS_BYTES, stream);
    if (e != hipSuccess) fprintf(stderr, "cooperative launch failed: %s (grid %d)\n", hipGetErrorString(e), grid);
}
```

```cpp
#include <hip/hip_runtime.h>
#include <hip/hip_cooperative_groups.h>
#include <cstdio>
#include <cstdint>
namespace cg = cooperative_groups;
namespace pg8 {
#define PG8_LAS __attribute__((address_space(3)))
typedef unsigned short bf16_t;
typedef short bf16x8 __attribute__((ext_vector_type(8)));
typedef float f32x4 __attribute__((ext_vector_type(4)));
typedef unsigned u32x4 __attribute__((ext_vector_type(4)));
constexpr int BM = 256, BK = 64, HALF = 128, HTB = HALF * BK * 2  , STAGE_BYTES = 8 * HTB, NXCD = 8, WGM = 8;

__host__ __device__ __forceinline__ int lds_byte(int r, int c) { const int st = (r >> 4) * 2 + (c >> 5), rr = r & 15, cc = c & 31, ob = rr * 64 + cc * 2; return st * 1024 + (ob ^ (((ob >> 9) & 1) << 5)); }
__host__ __device__ __forceinline__ void stage_rc(int b, int& R, int& C) { const int st = b / 1024, sb = b % 1024, swz = sb ^ (((sb >> 9) & 1) << 5); R = (st >> 1) * 16 + swz / 64; C = (st & 1) * 32 + (swz % 64) / 2; }
__host__ __device__ __forceinline__ int perm32(int rho) { const int n = rho >> 4, i = rho & 15; return 8 * (i >> 2) + 4 * n + (i & 3); }

struct Unit { int pm, pn; };
struct Gemm { const bf16_t* A; const bf16_t* Bt; int M, N, K; const bf16_t* A2; const bf16_t* Bt2; };

struct StaticOrder {
    int nM, nN, nwg, G, c;
    __host__ __device__ void init(int M, int N, int G_, int c_) { nM = M / BM; nN = N / BM; nwg = nM * nN; G = G_; c = c_; }
    __host__ __device__ bool next(int i, Unit& u) const {
        const long L = (long)i * G + c; if (L >= nwg) return false;
        int wgid = (int)L; { const int q = nwg / NXCD, r = nwg % NXCD, xcd = wgid % NXCD, off = wgid / NXCD; wgid = (xcd < r ? xcd * (q + 1) : r * (q + 1) + (xcd - r) * q) + off; }
        const int nig = WGM * nN, gid = wgid / nig, fm = gid * WGM, gsz = (nM - fm) < WGM ? (nM - fm) : WGM;
        u.pm = fm + ((wgid % nig) % gsz); u.pn = (wgid % nig) / gsz; return true;
    }
    __device__ __forceinline__ void a_ready(const Unit&) const {}
    __device__ __forceinline__ void done(const Unit&) const {}
};

__device__ __forceinline__ unsigned cvt_pk_bf16(float lo, float hi) { unsigned r; asm volatile("v_cvt_pk_bf16_f32 %0, %1, %2" : "=v"(r) : "v"(lo), "v"(hi)); return r; }
__device__ __forceinline__ float bf_lo(unsigned w) { return __uint_as_float(w << 16); }
__device__ __forceinline__ float bf_hi(unsigned w) { return __uint_as_float(w & 0xffff0000u); }
__device__ __forceinline__ float sigmoidf_fast(float v) { return __builtin_amdgcn_rcpf(1.0f + __builtin_amdgcn_exp2f(-1.4426950408889634f * v)); }
__device__ __forceinline__ float gelu_tanh(float v) { const float u = v * (1.0f + 0.044715f * v * v); return v * __builtin_amdgcn_rcpf(1.0f + __builtin_amdgcn_exp2f(-2.302208198f * u)); }

template <int MODE> struct Epi {
    static constexpr bool PERM = true, AFTER_DRAIN = false;
    bf16_t* O; float* F; const float* X; const bf16_t* G; float* SS; int ldo; int split_cols; size_t split_stride; int scale_tile; float scale;
    __device__ __forceinline__ void operator()(const f32x4 (&acc)[2][2][4][2], const Unit& u, int wr, int wc, int fr, int fq) const {
        const int row0 = u.pm * BM + wr * 64 + fr;
        int colt = u.pn * BM; bf16_t* obase = O; float sc = 1.f;
        if (MODE == 0 || MODE == 4) { if (split_cols) { const int t = colt / split_cols; obase += (size_t)t * split_stride; colt -= t * split_cols; if (MODE == 0 && t == scale_tile) sc = scale; } }
        const int col0 = colt + wc * 32 + 8 * fq;
        const int gcol0 = u.pn * BM + wc * 32 + 8 * fq;
#pragma unroll
        for (int ai = 0; ai < 2; ++ai)
#pragma unroll
            for (int m = 0; m < 4; ++m) {
                const int row = row0 + ai * HALF + m * 16;
                float rs = 1.f;
                if (MODE == 4) rs = __builtin_amdgcn_rsqf(SS[row] * (1.0f / 1024.0f) + 1e-6f);
                float ssq = 0.f;
#pragma unroll
                for (int bj = 0; bj < 2; ++bj) {
                    f32x4 v0 = acc[ai][bj][m][0], v1 = acc[ai][bj][m][1];
                    if (MODE == 0) { v0 = v0 * sc; v1 = v1 * sc; }
                    if (MODE == 4) { v0 = v0 * rs; v1 = v1 * rs; }
                    if (MODE == 1 || MODE == 2) {
                        const u32x4 g = *(const u32x4*)(G + (size_t)row * 1024 + gcol0 + bj * HALF);
                        v0[0] *= sigmoidf_fast(bf_lo(g.x)); v0[1] *= sigmoidf_fast(bf_hi(g.x)); v0[2] *= sigmoidf_fast(bf_lo(g.y)); v0[3] *= sigmoidf_fast(bf_hi(g.y));
                        v1[0] *= sigmoidf_fast(bf_lo(g.z)); v1[1] *= sigmoidf_fast(bf_hi(g.z)); v1[2] *= sigmoidf_fast(bf_lo(g.w)); v1[3] *= sigmoidf_fast(bf_hi(g.w));
                    }
                    if (MODE == 1) { float* fp = F + (size_t)row * 1024 + gcol0 + bj * HALF; *(f32x4*)fp = v0; *(f32x4*)(fp + 4) = v1; }
                    if (MODE == 2) { const float* fp = F + (size_t)row * 1024 + gcol0 + bj * HALF; v0 = v0 + *(const f32x4*)fp; v1 = v1 + *(const f32x4*)(fp + 4); }
                    if (MODE == 3) { const float* xp = X + (size_t)row * 1024 + gcol0 + bj * HALF; v0 = v0 + *(const f32x4*)xp; v1 = v1 + *(const f32x4*)(xp + 4);
                        ssq += (v0[0] * v0[0] + v0[1] * v0[1]) + (v0[2] * v0[2] + v0[3] * v0[3]) + (v1[0] * v1[0] + v1[1] * v1[1]) + (v1[2] * v1[2] + v1[3] * v1[3]); }
                    if (MODE == 5) { const u32x4 g = *(const u32x4*)(G + (size_t)row * 1024 + gcol0 + bj * HALF);
                        v0[0] += bf_lo(g.x); v0[1] += bf_hi(g.x); v0[2] += bf_lo(g.y); v0[3] += bf_hi(g.y); v1[0] += bf_lo(g.z); v1[1] += bf_hi(g.z); v1[2] += bf_lo(g.w); v1[3] += bf_hi(g.w);
                        ssq += (v0[0] * v0[0] + v0[1] * v0[1]) + (v0[2] * v0[2] + v0[3] * v0[3]) + (v1[0] * v1[0] + v1[1] * v1[1]) + (v1[2] * v1[2] + v1[3] * v1[3]); }
                    if (MODE == 0 || MODE == 2 || MODE == 3 || MODE == 4 || MODE == 5) {
                        u32x4 w; w.x = cvt_pk_bf16(v0[0], v0[1]); w.y = cvt_pk_bf16(v0[2], v0[3]); w.z = cvt_pk_bf16(v1[0], v1[1]); w.w = cvt_pk_bf16(v1[2], v1[3]);
                        *(u32x4*)(obase + (size_t)row * ldo + col0 + bj * HALF) = w; }
                }
                if (MODE == 3 || MODE == 5) { ssq += __shfl_xor(ssq, 16); ssq += __shfl_xor(ssq, 32); if (fq == 0) atomicAdd(SS + row, ssq); }
            }
    }
};

__device__ __forceinline__ float dpp_row_shr1(float oldv, float src) { return __builtin_bit_cast(float, __builtin_amdgcn_update_dpp(__builtin_bit_cast(int, oldv), __builtin_bit_cast(int, src), 0x111, 0xf, 0xf, false)); }
__device__ __forceinline__ float dpp_row_shr2(float oldv, float src) { return __builtin_bit_cast(float, __builtin_amdgcn_update_dpp(__builtin_bit_cast(int, oldv), __builtin_bit_cast(int, src), 0x112, 0xf, 0xf, false)); }
__device__ __forceinline__ float dpp_row_ror1(float src) { return __builtin_bit_cast(float, __builtin_amdgcn_update_dpp(0, __builtin_bit_cast(int, src), 0x121, 0xf, 0xf, false)); }
__device__ __forceinline__ float dpp_row_ror2(float src) { return __builtin_bit_cast(float, __builtin_amdgcn_update_dpp(0, __builtin_bit_cast(int, src), 0x122, 0xf, 0xf, false)); }
struct EpiAct {
    static constexpr bool PERM = true, AFTER_DRAIN = false;
    bf16_t* ACT; const float* SS; const float* cw; const float* cb; bf16_t* SG; bf16_t* SV;
    __device__ __forceinline__ void operator()(const f32x4 (&acc)[2][2][4][2], const Unit& u, int wr, int wc, int fr, int fq) const {
        const int ch0 = u.pn * 128 + wc * 32 + 8 * fq;
        float w0[8], w1[8], w2[8], bb[8];
        { const f32x4 a = *(const f32x4*)(cw + ch0), b = *(const f32x4*)(cw + ch0 + 4); w0[0] = a[0]; w0[1] = a[1]; w0[2] = a[2]; w0[3] = a[3]; w0[4] = b[0]; w0[5] = b[1]; w0[6] = b[2]; w0[7] = b[3]; }
        { const f32x4 a = *(const f32x4*)(cw + 3072 + ch0), b = *(const f32x4*)(cw + 3072 + ch0 + 4); w1[0] = a[0]; w1[1] = a[1]; w1[2] = a[2]; w1[3] = a[3]; w1[4] = b[0]; w1[5] = b[1]; w1[6] = b[2]; w1[7] = b[3]; }
        { const f32x4 a = *(const f32x4*)(cw + 6144 + ch0), b = *(const f32x4*)(cw + 6144 + ch0 + 4); w2[0] = a[0]; w2[1] = a[1]; w2[2] = a[2]; w2[3] = a[3]; w2[4] = b[0]; w2[5] = b[1]; w2[6] = b[2]; w2[7] = b[3]; }
        { const f32x4 a = *(const f32x4*)(cb + ch0), b = *(const f32x4*)(cb + ch0 + 4); bb[0] = a[0]; bb[1] = a[1]; bb[2] = a[2]; bb[3] = a[3]; bb[4] = b[0]; bb[5] = b[1]; bb[6] = b[2]; bb[7] = b[3]; }
        float ssr[2][4];
#pragma unroll
        for (int ai = 0; ai < 2; ++ai)
#pragma unroll
            for (int m = 0; m < 4; ++m) ssr[ai][m] = SS[(u.pm * 4 + ai * 2 + wr) * 64 + m * 16 + fr];
#pragma unroll
        for (int ai = 0; ai < 2; ++ai) {
            const int strip = u.pm * 4 + ai * 2 + wr;
            float gp[8];
#pragma unroll
            for (int e = 0; e < 8; ++e) gp[e] = 0.f;
#pragma unroll
            for (int m = 0; m < 4; ++m) {
                const int row = strip * 64 + m * 16 + fr;
                const float rs = __builtin_amdgcn_rsqf(ssr[ai][m] * (1.0f / 1024.0f) + 1e-6f);
                float g[8], v[8], o[8];
#pragma unroll
                for (int e = 0; e < 4; ++e) { g[e] = acc[ai][0][m][0][e] * rs; g[4 + e] = acc[ai][0][m][1][e] * rs; v[e] = acc[ai][1][m][0][e] * rs; v[4 + e] = acc[ai][1][m][1][e] * rs; }
#pragma unroll
                for (int e = 0; e < 8; e += 2) { typedef float f2 __attribute__((ext_vector_type(2)));
                    const f2 r1 = (f2){dpp_row_shr1(dpp_row_ror1(gp[e]), g[e]), dpp_row_shr1(dpp_row_ror1(gp[e + 1]), g[e + 1])};
                    const f2 r2 = (f2){dpp_row_shr2(dpp_row_ror2(gp[e]), g[e]), dpp_row_shr2(dpp_row_ror2(gp[e + 1]), g[e + 1])};
                    const f2 c = (f2){bb[e], bb[e + 1]} + (f2){w0[e], w0[e + 1]} * r2 + (f2){w1[e], w1[e + 1]} * r1 + (f2){w2[e], w2[e + 1]} * (f2){g[e], g[e + 1]};
                    f2 t = c * (c * c * 0.044715f + 1.0f) * (-2.302208198f);
                    t.x = __builtin_amdgcn_exp2f(t.x); t.y = __builtin_amdgcn_exp2f(t.y); t = t + 1.0f;
                    f2 q; q.x = __builtin_amdgcn_rcpf(t.x); q.y = __builtin_amdgcn_rcpf(t.y);
                    const f2 ov = c * q * (f2){v[e], v[e + 1]}; o[e] = ov.x; o[e + 1] = ov.y; }
                u32x4 w; w.x = cvt_pk_bf16(o[0], o[1]); w.y = cvt_pk_bf16(o[2], o[3]); w.z = cvt_pk_bf16(o[4], o[5]); w.w = cvt_pk_bf16(o[6], o[7]);
                *(u32x4*)(ACT + (size_t)row * 3072 + ch0) = w;
                if (m == 0 && fr < 2) { u32x4 gw, vw; gw.x = cvt_pk_bf16(g[0], g[1]); gw.y = cvt_pk_bf16(g[2], g[3]); gw.z = cvt_pk_bf16(g[4], g[5]); gw.w = cvt_pk_bf16(g[6], g[7]);
                    vw.x = cvt_pk_bf16(v[0], v[1]); vw.y = cvt_pk_bf16(v[2], v[3]); vw.z = cvt_pk_bf16(v[4], v[5]); vw.w = cvt_pk_bf16(v[6], v[7]);
                    *(u32x4*)(SG + ((size_t)strip * 4 + 2 + fr) * 3072 + ch0) = gw; *(u32x4*)(SV + ((size_t)strip * 2 + fr) * 3072 + ch0) = vw; }
                if (m == 3 && fr >= 14) { u32x4 gw; gw.x = cvt_pk_bf16(g[0], g[1]); gw.y = cvt_pk_bf16(g[2], g[3]); gw.z = cvt_pk_bf16(g[4], g[5]); gw.w = cvt_pk_bf16(g[6], g[7]);
                    *(u32x4*)(SG + ((size_t)strip * 4 + (fr - 14)) * 3072 + ch0) = gw; }
#pragma unroll
                for (int e = 0; e < 8; ++e) gp[e] = g[e];
            }
        }
    }
};


#define PG8_FENCE() asm volatile("" ::: "memory")
struct EpiRes3 {
    static constexpr bool PERM = true, AFTER_DRAIN = false;
    bf16_t* O; const float* X; float* SS;
    __device__ __forceinline__ void operator()(const f32x4 (&acc)[2][2][4][2], const Unit& u, int wr, int wc, int fr, int fq) const {
        const int row0 = u.pm * BM + wr * 64 + fr, col0 = u.pn * BM + wc * 32 + 8 * fq;
        f32x4 xb[2][2][2][2];
#define PG8_LDX(buf, b) do { const int ai_ = (b) >> 1, mp_ = (b) & 1; _Pragma("unroll") for (int mm = 0; mm < 2; ++mm) _Pragma("unroll") for (int bj = 0; bj < 2; ++bj) { \
            const float* xp = X + (size_t)(row0 + ai_ * HALF + (mp_ * 2 + mm) * 16) * 1024 + col0 + bj * HALF; xb[buf][mm][bj][0] = *(const f32x4*)xp; xb[buf][mm][bj][1] = *(const f32x4*)(xp + 4); } } while (0)
        PG8_LDX(0, 0);
#pragma unroll
        for (int b = 0; b < 4; ++b) {
            if (b + 1 < 4) { if ((b & 1) == 0) PG8_LDX(1, b + 1); else PG8_LDX(0, b + 1); }
            PG8_FENCE();
            const int ai = b >> 1, mp = b & 1;
#pragma unroll
            for (int mm = 0; mm < 2; ++mm) { const int m = mp * 2 + mm, row = row0 + ai * HALF + m * 16; float ssq = 0.f;
#pragma unroll
                for (int bj = 0; bj < 2; ++bj) { const f32x4 v0 = acc[ai][bj][m][0] + xb[b & 1][mm][bj][0], v1 = acc[ai][bj][m][1] + xb[b & 1][mm][bj][1];
                    ssq += (v0[0] * v0[0] + v0[1] * v0[1]) + (v0[2] * v0[2] + v0[3] * v0[3]) + (v1[0] * v1[0] + v1[1] * v1[1]) + (v1[2] * v1[2] + v1[3] * v1[3]);
                    u32x4 w; w.x = cvt_pk_bf16(v0[0], v0[1]); w.y = cvt_pk_bf16(v0[2], v0[3]); w.z = cvt_pk_bf16(v1[0], v1[1]); w.w = cvt_pk_bf16(v1[2], v1[3]);
                    *(u32x4*)(O + (size_t)row * 1024 + col0 + bj * HALF) = w; }
                ssq += __shfl_xor(ssq, 16); ssq += __shfl_xor(ssq, 32); if (fq == 0) atomicAdd(SS + row, ssq); }
            PG8_FENCE();
        }
#undef PG8_LDX
    }
};
struct EpiRes5 {
    static constexpr bool PERM = true, AFTER_DRAIN = false;
    bf16_t* O; const bf16_t* G; float* SS;
    __device__ __forceinline__ void operator()(const f32x4 (&acc)[2][2][4][2], const Unit& u, int wr, int wc, int fr, int fq) const {
        const int row0 = u.pm * BM + wr * 64 + fr, col0 = u.pn * BM + wc * 32 + 8 * fq;
        u32x4 gb[2][4][2];
#pragma unroll
        for (int ai = 0; ai < 2; ++ai)
#pragma unroll
            for (int m = 0; m < 4; ++m)
#pragma unroll
                for (int bj = 0; bj < 2; ++bj) gb[ai][m][bj] = *(const u32x4*)(G + (size_t)(row0 + ai * HALF + m * 16) * 1024 + col0 + bj * HALF);
        PG8_FENCE();
#pragma unroll
        for (int ai = 0; ai < 2; ++ai)
#pragma unroll
            for (int m = 0; m < 4; ++m) { const int row = row0 + ai * HALF + m * 16; float ssq = 0.f;
#pragma unroll
                for (int bj = 0; bj < 2; ++bj) { const u32x4 g = gb[ai][m][bj]; f32x4 v0 = acc[ai][bj][m][0], v1 = acc[ai][bj][m][1];
                    v0[0] += bf_lo(g.x); v0[1] += bf_hi(g.x); v0[2] += bf_lo(g.y); v0[3] += bf_hi(g.y); v1[0] += bf_lo(g.z); v1[1] += bf_hi(g.z); v1[2] += bf_lo(g.w); v1[3] += bf_hi(g.w);
                    ssq += (v0[0] * v0[0] + v0[1] * v0[1]) + (v0[2] * v0[2] + v0[3] * v0[3]) + (v1[0] * v1[0] + v1[1] * v1[1]) + (v1[2] * v1[2] + v1[3] * v1[3]);
                    u32x4 w; w.x = cvt_pk_bf16(v0[0], v0[1]); w.y = cvt_pk_bf16(v0[2], v0[3]); w.z = cvt_pk_bf16(v1[0], v1[1]); w.w = cvt_pk_bf16(v1[2], v1[3]);
                    *(u32x4*)(O + (size_t)row * 1024 + col0 + bj * HALF) = w; }
                ssq += __shfl_xor(ssq, 16); ssq += __shfl_xor(ssq, 32); if (fq == 0) atomicAdd(SS + row, ssq); }
    }
};


struct EpiRes5F {
    static constexpr bool PERM = true, AFTER_DRAIN = false;
    float* OUT; const bf16_t* G; float* SS; const float* gf; unsigned* cnt;
    __device__ __forceinline__ void operator()(const f32x4 (&acc)[2][2][4][2], const Unit& u, int wr, int wc, int fr, int fq) const {
        const int row0 = u.pm * BM + wr * 64 + fr, col0 = u.pn * BM + wc * 32 + 8 * fq;
        u32x4 gb[2][4][2];
#pragma unroll
        for (int ai = 0; ai < 2; ++ai)
#pragma unroll
            for (int m = 0; m < 4; ++m)
#pragma unroll
                for (int bj = 0; bj < 2; ++bj) gb[ai][m][bj] = *(const u32x4*)(G + (size_t)(row0 + ai * HALF + m * 16) * 1024 + col0 + bj * HALF);
        PG8_FENCE();
        f32x4 v[2][4][2][2];
#pragma unroll
        for (int ai = 0; ai < 2; ++ai)
#pragma unroll
            for (int m = 0; m < 4; ++m) { const int row = row0 + ai * HALF + m * 16; float ssq = 0.f;
#pragma unroll
                for (int bj = 0; bj < 2; ++bj) { const u32x4 g = gb[ai][m][bj]; f32x4 v0 = acc[ai][bj][m][0], v1 = acc[ai][bj][m][1];
                    v0[0] += bf_lo(g.x); v0[1] += bf_hi(g.x); v0[2] += bf_lo(g.y); v0[3] += bf_hi(g.y); v1[0] += bf_lo(g.z); v1[1] += bf_hi(g.z); v1[2] += bf_lo(g.w); v1[3] += bf_hi(g.w);
                    ssq += (v0[0] * v0[0] + v0[1] * v0[1]) + (v0[2] * v0[2] + v0[3] * v0[3]) + (v1[0] * v1[0] + v1[1] * v1[1]) + (v1[2] * v1[2] + v1[3] * v1[3]);
                    v[ai][m][bj][0] = v0; v[ai][m][bj][1] = v1; }
                ssq += __shfl_xor(ssq, 16); ssq += __shfl_xor(ssq, 32); if (fq == 0) atomicAdd(SS + row, ssq); }
        asm volatile("s_waitcnt vmcnt(0)" ::: "memory");
        unsigned* pc = cnt + 64 * u.pm;
        if (fr == 0 && fq == 0) __hip_atomic_fetch_add(pc, 1u, __ATOMIC_RELAXED, __HIP_MEMORY_SCOPE_AGENT);
        f32x4 gv[2][2];
#pragma unroll
        for (int bj = 0; bj < 2; ++bj) { gv[bj][0] = *(const f32x4*)(gf + col0 + bj * HALF); gv[bj][1] = *(const f32x4*)(gf + col0 + bj * HALF + 4); }
        { unsigned sp = 0;
          while ((unsigned)__builtin_amdgcn_readfirstlane(__hip_atomic_load(pc, __ATOMIC_RELAXED, __HIP_MEMORY_SCOPE_AGENT)) < 32u) { __builtin_amdgcn_s_sleep(2); if (++sp > (1u << 20)) break; } }
        PG8_FENCE();
#pragma unroll
        for (int ai = 0; ai < 2; ++ai)
#pragma unroll
            for (int m = 0; m < 4; ++m) { const int row = row0 + ai * HALF + m * 16;
                const float rs = __builtin_amdgcn_rsqf(__hip_atomic_load(SS + row, __ATOMIC_RELAXED, __HIP_MEMORY_SCOPE_AGENT) * (1.0f / 1024.0f) + 1e-6f);
#pragma unroll
                for (int bj = 0; bj < 2; ++bj) { float* op = OUT + (size_t)row * 1024 + col0 + bj * HALF;
                    *(f32x4*)op = v[ai][m][bj][0] * rs * gv[bj][0]; *(f32x4*)(op + 4) = v[ai][m][bj][1] * rs * gv[bj][1]; } }
    }
};
struct RoundOrder {
    StaticOrder base; int k;
    __device__ __forceinline__ bool next(int i, Unit& u) const { return i == 0 ? base.next(k, u) : false; }
    __device__ __forceinline__ void a_ready(const Unit&) const {}
    __device__ __forceinline__ void done(const Unit&) const {}
};

struct EpiMerge {
    static constexpr bool PERM = true, AFTER_DRAIN = false;
    bf16_t* O; const bf16_t* G1; const bf16_t* G2;
    __device__ __forceinline__ void mid(f32x4 (&acc)[2][2][4][2], const Unit& u, int wr, int wc, int fr, int fq) const {
        const int row0 = u.pm * BM + wr * 64 + fr, gcol0 = u.pn * BM + wc * 32 + 8 * fq;
#pragma unroll
        for (int ai = 0; ai < 2; ++ai) {
            u32x4 ga[4][2], gb[4][2];
#pragma unroll
            for (int m = 0; m < 4; ++m)
#pragma unroll
                for (int bj = 0; bj < 2; ++bj) { const size_t off = (size_t)(row0 + ai * HALF + m * 16) * 1024 + gcol0 + bj * HALF; ga[m][bj] = *(const u32x4*)(G1 + off); gb[m][bj] = *(const u32x4*)(G2 + off); }
            PG8_FENCE();
#pragma unroll
            for (int m = 0; m < 4; ++m)
#pragma unroll
                for (int bj = 0; bj < 2; ++bj) { const u32x4 a = ga[m][bj], b = gb[m][bj];
                    const unsigned A[4] = {a.x, a.y, a.z, a.w}, B[4] = {b.x, b.y, b.z, b.w};
#pragma unroll
                    for (int q = 0; q < 4; ++q) { const float nl = -1.4426950408889634f;
                        const float r0 = (1.0f + __builtin_amdgcn_exp2f(nl * bf_lo(B[q]))) * __builtin_amdgcn_rcpf(1.0f + __builtin_amdgcn_exp2f(nl * bf_lo(A[q])));
                        const float r1 = (1.0f + __builtin_amdgcn_exp2f(nl * bf_hi(B[q]))) * __builtin_amdgcn_rcpf(1.0f + __builtin_amdgcn_exp2f(nl * bf_hi(A[q])));
                        acc[ai][bj][m][q >> 1][(q & 1) * 2] *= r0; acc[ai][bj][m][q >> 1][(q & 1) * 2 + 1] *= r1; } }
            PG8_FENCE();
        }
    }
    __device__ __forceinline__ void operator()(const f32x4 (&acc)[2][2][4][2], const Unit& u, int wr, int wc, int fr, int fq) const {
        const int row0 = u.pm * BM + wr * 64 + fr, gcol0 = u.pn * BM + wc * 32 + 8 * fq;
        u32x4 gall[2][4][2];
#pragma unroll
        for (int ai = 0; ai < 2; ++ai)
#pragma unroll
            for (int m = 0; m < 4; ++m)
#pragma unroll
                for (int bj = 0; bj < 2; ++bj) gall[ai][m][bj] = *(const u32x4*)(G2 + (size_t)(row0 + ai * HALF + m * 16) * 1024 + gcol0 + bj * HALF);
        PG8_FENCE();
#pragma unroll
        for (int ai = 0; ai < 2; ++ai)
#pragma unroll
            for (int m = 0; m < 4; ++m)
#pragma unroll
                for (int bj = 0; bj < 2; ++bj) { const size_t off = (size_t)(row0 + ai * HALF + m * 16) * 1024 + gcol0 + bj * HALF;
                    const u32x4 b = gall[ai][m][bj]; const f32x4 v0 = acc[ai][bj][m][0], v1 = acc[ai][bj][m][1];
                    u32x4 w; w.x = cvt_pk_bf16(v0[0] * sigmoidf_fast(bf_lo(b.x)), v0[1] * sigmoidf_fast(bf_hi(b.x))); w.y = cvt_pk_bf16(v0[2] * sigmoidf_fast(bf_lo(b.y)), v0[3] * sigmoidf_fast(bf_hi(b.y)));
                    w.z = cvt_pk_bf16(v1[0] * sigmoidf_fast(bf_lo(b.z)), v1[1] * sigmoidf_fast(bf_hi(b.z))); w.w = cvt_pk_bf16(v1[2] * sigmoidf_fast(bf_lo(b.w)), v1[3] * sigmoidf_fast(bf_hi(b.w)));
                    *(u32x4*)(O + off) = w; }
    }
};

template <class Epi, class Sched, bool ALIGN_EPI = false, bool SP2 = false, bool PAIR = false>
__device__ __forceinline__ void gemm_phase(PG8_LAS unsigned char* lds, const Gemm g, const Sched& S, const Epi& E) {
    int tid_l = threadIdx.x; asm volatile("" : "+v"(tid_l));
    const int tid = tid_l, wid = __builtin_amdgcn_readfirstlane(tid >> 6), lane = tid & 63, wr = wid >> 2, wc = wid & 3, fr = lane & 15, fq = lane >> 4;
    const int K = g.K, nt = K / BK;
    unsigned voffA[2], voffB[2];
#pragma unroll
    for (int i = 0; i < 2; ++i) { int R, C; stage_rc(tid * 16 + i * 8192, R, C); const int Rb = Epi::PERM ? ((R & ~31) + perm32(R & 31)) : R;
        voffA[i] = (unsigned)(R * K + C) * 2u; voffB[i] = (unsigned)(Rb * K + C) * 2u; }
    const size_t kstep = (size_t)(BK * 2);
    const size_t hstep = (size_t)HALF * K * 2;
    const size_t tstep = 2 * hstep;
    const unsigned ldsw = (unsigned)wid * 1024u;
    const int aoff = lds_byte(wr * 64 + fr, fq * 8), boff = lds_byte(wc * 32 + fr, fq * 8);
#define PG8_SA(b, h) (((b) * 2 + (h)) * HTB)
#define PG8_SB(b, h) ((4 + (b) * 2 + (h)) * HTB)
#define PG8_STAGE(bufoff, gbase, voff) do { _Pragma("unroll") for (int _i = 0; _i < 2; ++_i) \
        __builtin_amdgcn_global_load_lds((const unsigned*)((const char*)(gbase) + (voff)[_i]), (PG8_LAS unsigned*)(lds + (bufoff) + ldsw + _i * 8192), 16, 0, 0); } while (0)
#define PG8_LDA(dst, b, h) do { _Pragma("unroll") for (int m = 0; m < 4; ++m) _Pragma("unroll") for (int k = 0; k < 2; ++k) dst[m][k] = *(const PG8_LAS bf16x8*)(lds + PG8_SA(b, h) + aoff + m * 2048 + k * 1024); } while (0)
#define PG8_LDB(dst, b, h) do { _Pragma("unroll") for (int n = 0; n < 2; ++n) _Pragma("unroll") for (int k = 0; k < 2; ++k) dst[n][k] = *(const PG8_LAS bf16x8*)(lds + PG8_SB(b, h) + boff + n * 2048 + k * 1024); } while (0)
#define PG8_MMA(ai, bj, At, Bt) do { __builtin_amdgcn_s_setprio(1); _Pragma("unroll") for (int m = 0; m < 4; ++m) _Pragma("unroll") for (int n = 0; n < 2; ++n) _Pragma("unroll") for (int k = 0; k < 2; ++k) \
        acc[ai][bj][m][n] = __builtin_amdgcn_mfma_f32_16x16x32_bf16(Bt[n][k], At[m][k], acc[ai][bj][m][n], 0, 0, 0); __builtin_amdgcn_s_setprio(0); } while (0)
#define PG8_WAIT_V(n) asm volatile("s_waitcnt vmcnt(" #n ")" ::: "memory")
#define PG8_WAIT_L(n) asm volatile("s_waitcnt lgkmcnt(" #n ")" ::: "memory")
#define PG8_BAR __builtin_amdgcn_s_barrier()
#define PG8_SCHED __builtin_amdgcn_sched_barrier(0)
    Unit cur, nxt; int ui = 0;
    if (!S.next(0, cur)) return;
    f32x4 acc[2][2][4][2];
#pragma unroll
    for (int a = 0; a < 2; ++a)
#pragma unroll
        for (int b = 0; b < 2; ++b)
#pragma unroll
            for (int m = 0; m < 4; ++m)
#pragma unroll
                for (int n = 0; n < 2; ++n) acc[a][b][m][n] = (f32x4){0.f, 0.f, 0.f, 0.f};
    bf16x8 At[4][2], B0[2][2], B1[2][2];
    const char* cA = (const char*)g.A + (size_t)cur.pm * tstep; const char* cB = (const char*)g.Bt + (size_t)cur.pn * tstep;
    S.a_ready(cur);
    if constexpr (SP2) {
        PG8_STAGE(PG8_SB(0, 0), cB, voffB); PG8_STAGE(PG8_SB(0, 1), cB + hstep, voffB); PG8_STAGE(PG8_SA(0, 0), cA, voffA); PG8_STAGE(PG8_SA(0, 1), cA + hstep, voffA);
        if (wr == 1) PG8_BAR;
        PG8_WAIT_V(2); PG8_BAR;
        PG8_STAGE(PG8_SB(1, 0), cB + kstep, voffB); PG8_STAGE(PG8_SA(1, 0), cA + kstep, voffA); PG8_STAGE(PG8_SB(1, 1), cB + hstep + kstep, voffB);
        PG8_WAIT_V(6); PG8_BAR;
    } else {
        PG8_STAGE(PG8_SB(0, 0), cB, voffB); PG8_STAGE(PG8_SA(0, 0), cA, voffA); PG8_STAGE(PG8_SB(0, 1), cB + hstep, voffB); PG8_STAGE(PG8_SA(0, 1), cA + hstep, voffA);
        if (wr == 1) PG8_BAR;
        PG8_WAIT_V(4); PG8_BAR;
        PG8_STAGE(PG8_SB(1, 0), cB + kstep, voffB); PG8_STAGE(PG8_SA(1, 0), cA + kstep, voffA); PG8_STAGE(PG8_SB(1, 1), cB + hstep + kstep, voffB);
        PG8_WAIT_V(6); PG8_BAR;
    }
    for (;;) {
        const bool has_next = PAIR ? S.next((ui + 1) >> 1, nxt) : S.next(ui + 1, nxt);
        const bf16_t* gA_n = (PAIR && ((ui + 1) & 1)) ? g.A2 : g.A; const bf16_t* gB_n = (PAIR && ((ui + 1) & 1)) ? g.Bt2 : g.Bt;
        const char* nA = has_next ? (const char*)gA_n + (size_t)nxt.pm * tstep : cA; const char* nB = has_next ? (const char*)gB_n + (size_t)nxt.pn * tstep : cB;
        for (int t = 0; t < nt; t += 2) {
            const bool last = (t == nt - 2);
            const char* a1 = cA + (size_t)(t + 1) * kstep;
            const char* a2 = last ? nA : cA + (size_t)(t + 2) * kstep; const char* b2 = last ? nB : cB + (size_t)(t + 2) * kstep;
            const char* a3 = a2 + kstep; const char* b3 = b2 + kstep;
            if (last && has_next) S.a_ready(nxt);
            if constexpr (SP2) {
            PG8_LDB(B0, 0, 0); PG8_LDB(B1, 0, 1); PG8_SCHED; PG8_LDA(At, 0, 0); PG8_STAGE(PG8_SA(1, 1), a1 + hstep, voffA);
            PG8_WAIT_V(8); PG8_WAIT_L(0); PG8_BAR; PG8_MMA(0, 0, At, B0); PG8_MMA(0, 1, At, B1); PG8_BAR; PG8_SCHED;
            PG8_LDA(At, 0, 1); PG8_STAGE(PG8_SB(0, 0), b2, voffB); PG8_STAGE(PG8_SB(0, 1), b2 + hstep, voffB); PG8_STAGE(PG8_SA(0, 0), a2, voffA);
            PG8_WAIT_V(8); PG8_WAIT_L(0); PG8_BAR; PG8_MMA(1, 0, At, B0); PG8_MMA(1, 1, At, B1); PG8_BAR; PG8_SCHED;
            PG8_LDB(B0, 1, 0); PG8_LDB(B1, 1, 1); PG8_SCHED; PG8_LDA(At, 1, 0); PG8_STAGE(PG8_SA(0, 1), a2 + hstep, voffA);
            PG8_WAIT_V(8); PG8_WAIT_L(0); PG8_BAR; PG8_MMA(0, 0, At, B0); PG8_MMA(0, 1, At, B1); PG8_BAR; PG8_SCHED;
            PG8_LDA(At, 1, 1); PG8_STAGE(PG8_SB(1, 0), b3, voffB); PG8_STAGE(PG8_SB(1, 1), b3 + hstep, voffB); PG8_STAGE(PG8_SA(1, 0), a3, voffA);
            PG8_WAIT_V(8); PG8_WAIT_L(0); PG8_BAR; PG8_MMA(1, 0, At, B0); PG8_MMA(1, 1, At, B1); PG8_BAR; PG8_SCHED;
            } else {
            PG8_LDB(B0, 0, 0); PG8_SCHED; PG8_LDA(At, 0, 0); PG8_STAGE(PG8_SA(1, 1), a1 + hstep, voffA);
            PG8_WAIT_L(8); PG8_BAR; PG8_WAIT_L(0); PG8_MMA(0, 0, At, B0); PG8_BAR; PG8_SCHED;
            PG8_LDB(B1, 0, 1); PG8_STAGE(PG8_SB(0, 0), b2, voffB);
            PG8_BAR; PG8_WAIT_L(0); PG8_MMA(0, 1, At, B1); PG8_BAR;
            PG8_LDA(At, 0, 1); PG8_STAGE(PG8_SA(0, 0), a2, voffA);
            PG8_BAR; PG8_WAIT_L(0); PG8_MMA(1, 0, At, B0); PG8_BAR; PG8_SCHED;
            PG8_STAGE(PG8_SB(0, 1), b2 + hstep, voffB);
            PG8_WAIT_V(6); PG8_BAR; PG8_MMA(1, 1, At, B1); PG8_BAR;
            PG8_LDB(B0, 1, 0); PG8_SCHED; PG8_LDA(At, 1, 0); PG8_STAGE(PG8_SA(0, 1), a2 + hstep, voffA);
            PG8_WAIT_L(8); PG8_BAR; PG8_WAIT_L(0); PG8_MMA(0, 0, At, B0); PG8_BAR; PG8_SCHED;
            PG8_LDB(B1, 1, 1); PG8_STAGE(PG8_SB(1, 0), b3, voffB);
            PG8_BAR; PG8_WAIT_L(0); PG8_MMA(0, 1, At, B1); PG8_BAR;
            PG8_LDA(At, 1, 1); PG8_STAGE(PG8_SA(1, 0), a3, voffA);
            PG8_BAR; PG8_WAIT_L(0); PG8_MMA(1, 0, At, B0); PG8_BAR; PG8_SCHED;
            PG8_STAGE(PG8_SB(1, 1), b3 + hstep, voffB);
            PG8_WAIT_V(6); PG8_BAR; PG8_MMA(1, 1, At, B1); PG8_BAR;
            }
        }
        if constexpr (ALIGN_EPI) { if (wr == 0) PG8_BAR; }
        if constexpr (PAIR) { if ((ui & 1) == 0) E.mid(acc, cur, wr, wc, fr, fq); else E(acc, cur, wr, wc, fr, fq); }
        else if constexpr (!Epi::AFTER_DRAIN) { E(acc, cur, wr, wc, fr, fq); S.done(cur); }
        if (!has_next) break;
        if (!(PAIR && (ui & 1) == 0))
#pragma unroll
        for (int a = 0; a < 2; ++a)
#pragma unroll
            for (int b = 0; b < 2; ++b)
#pragma unroll
                for (int m = 0; m < 4; ++m)
#pragma unroll
                    for (int n = 0; n < 2; ++n) acc[a][b][m][n] = (f32x4){0.f, 0.f, 0.f, 0.f};
        cur = nxt; cA = nA; cB = nB; ++ui;
        if constexpr (ALIGN_EPI) { if (wr == 1) PG8_BAR; }
    }
    PG8_WAIT_V(0);
    if constexpr (!ALIGN_EPI) { if (wr == 0) PG8_BAR; }
    PG8_BAR;
    if constexpr (Epi::AFTER_DRAIN) { E.fused(acc, cur, wr, wc, fr, fq, lds, wid, lane); S.done(cur); }
#undef PG8_SA
#undef PG8_SB
#undef PG8_STAGE
#undef PG8_LDA
#undef PG8_LDB
#undef PG8_MMA
#undef PG8_WAIT_V
#undef PG8_WAIT_L
#undef PG8_BAR
#undef PG8_SCHED
}
}

#include <hip/hip_bf16.h>
#include <cmath>
namespace attn_body {
using bf16=__hip_bfloat16;
using bf16x8=__attribute__((ext_vector_type(8)))short;
using s16x4=__attribute__((ext_vector_type(4)))short;
using f32x16=__attribute__((ext_vector_type(16)))float;
using u32x4=__attribute__((ext_vector_type(4)))unsigned;
constexpr int BATCH=4,NHEAD=16,SEQ=8192,D=64,DM=NHEAD*D;
constexpr int NW=8,QBLK=32,QB=QBLK*NW,KVBLK=64,NQB=SEQ/QB;
constexpr int ATTN_PITCH=DM, ATTN_UNIT_ROWS=QB;
__device__ __forceinline__ int crow(int r,int hi){return (r&3)+8*(r>>2)+4*hi;}
#define SBAR() __builtin_amdgcn_sched_barrier(0)
__device__ __forceinline__ void cmask(f32x16&p0,f32x16&p1,int jb,int qrel,int hi){
  const float NEG=-INFINITY; int kb=64*jb+4*hi;
  #pragma unroll
  for(int r=0;r<16;++r){int kv=kb+(r&3)+8*(r>>2); if(kv>qrel)p0[r]=NEG; if(kv+32>qrel)p1[r]=NEG;}
}

constexpr int NSLOT=3, SLOTB=8192;
constexpr int LDS_K=0, LDS_V=NSLOT*SLOTB, LDS_WS=2*NSLOT*SLOTB, LDS_OST=LDS_WS+NW*64*4, LDS_BYTES=LDS_OST+NW*4096;
constexpr float C2=0.125f*1.4426950408889634f;
__device__ __forceinline__ void glds16(const void*gsrc,unsigned lds_dst){unsigned keep;
  asm volatile("s_mov_b32 %0, m0\n\ts_mov_b32 m0, %2\n\ts_nop 0\n\tglobal_load_lds_dwordx4 %1, off\n\ts_mov_b32 m0, %0":"=&s"(keep):"v"(gsrc),"s"(lds_dst):"memory");}
__device__ __forceinline__ float max3f(float a,float b,float c){float r;asm("v_max3_f32 %0, %1, %2, %3":"=v"(r):"v"(a),"v"(b),"v"(c));return r;}
__device__ __forceinline__ float max2f(float a,float b){float r;asm("v_max_f32_e32 %0, %1, %2":"=v"(r):"v"(a),"v"(b));return r;}
__device__ __forceinline__ float fadd_s(float a,float b){float r;asm("v_add_f32_e32 %0, %1, %2":"=v"(r):"v"(a),"v"(b));return r;}
__device__ __forceinline__ float fsub_s(float a,float b){float r;asm("v_sub_f32_e32 %0, %1, %2":"=v"(r):"v"(a),"v"(b));return r;}
typedef float f32x2_t __attribute__((ext_vector_type(2))); typedef __bf16 bf16x2_t __attribute__((ext_vector_type(2)));
__device__ __forceinline__ unsigned cvtpk_s(float lo,float hi){f32x2_t v={lo,hi};bf16x2_t b=__builtin_convertvector(v,bf16x2_t);return __builtin_bit_cast(unsigned,b);}
#define WAIT_BAR(N) asm volatile("s_waitcnt vmcnt(" #N ") lgkmcnt(0)\n\ts_barrier":::"memory")

__device__ __forceinline__ void qkt(f32x16&p0,f32x16&p1,const char*Kslot,const bf16x8*qr,const f32x16&negm,int r32,int hi){
  const char*kb=Kslot+hi*1024+r32*16;
  #pragma unroll
  for(int d0=0;d0<4;++d0){
    const bf16x8 b0=*reinterpret_cast<const bf16x8*>(kb+d0*2048);
    const bf16x8 b1=*reinterpret_cast<const bf16x8*>(kb+d0*2048+512);
    if(d0==0){p0=__builtin_amdgcn_mfma_f32_32x32x16_bf16(b0,qr[0],negm,0,0,0);p1=__builtin_amdgcn_mfma_f32_32x32x16_bf16(b1,qr[0],negm,0,0,0);}
    else{p0=__builtin_amdgcn_mfma_f32_32x32x16_bf16(b0,qr[d0],p0,0,0,0);p1=__builtin_amdgcn_mfma_f32_32x32x16_bf16(b1,qr[d0],p1,0,0,0);}}
}
typedef __attribute__((address_space(3))) const char* lds_cptr;
typedef short v4i16_t __attribute__((ext_vector_type(4)));
__device__ __forceinline__ void kload8(bf16x8*kf,lds_cptr kp){
  kf[0]=*(const __attribute__((address_space(3))) bf16x8*)(kp);      kf[1]=*(const __attribute__((address_space(3))) bf16x8*)(kp+512);
  kf[2]=*(const __attribute__((address_space(3))) bf16x8*)(kp+2048); kf[3]=*(const __attribute__((address_space(3))) bf16x8*)(kp+2560);
  kf[4]=*(const __attribute__((address_space(3))) bf16x8*)(kp+4096); kf[5]=*(const __attribute__((address_space(3))) bf16x8*)(kp+4608);
  kf[6]=*(const __attribute__((address_space(3))) bf16x8*)(kp+6144); kf[7]=*(const __attribute__((address_space(3))) bf16x8*)(kp+6656);
}
__device__ __forceinline__ void kload2(bf16x8*kf,lds_cptr kp,int j){ kf[2*j]=*(const __attribute__((address_space(3))) bf16x8*)(kp+j*2048); kf[2*j+1]=*(const __attribute__((address_space(3))) bf16x8*)(kp+j*2048+512); }
__device__ __forceinline__ s16x4 vtr(lds_cptr p){ return __builtin_bit_cast(s16x4,__builtin_amdgcn_ds_read_tr16_b64_v4i16((__attribute__((address_space(3))) v4i16_t*)p)); }
__device__ __forceinline__ float rowmax(const f32x16&p0,const f32x16&p1){
  float a=max3f(p0[0],p0[1],p1[0]),b=max3f(p0[2],p0[3],p1[1]);a=max3f(a,p1[2],p1[3]);
  #pragma unroll
  for(int r=4;r<16;r+=4){a=max3f(a,p0[r],p0[r+1]);b=max3f(b,p0[r+2],p0[r+3]);a=max3f(a,p1[r],p1[r+1]);b=max3f(b,p1[r+2],p1[r+3]);}
  const float m=max2f(a,b);
  auto rr=__builtin_amdgcn_permlane32_swap(__float_as_uint(m),__float_as_uint(m),false,false);
  return max2f(__uint_as_float(rr[0]),__uint_as_float(rr[1]));
}
__device__ __forceinline__ void pv(f32x16*o,int vb,bf16x8 pa0,bf16x8 pa1,bf16x8 pa2,bf16x8 pa3){
  #pragma unroll
  for(int d0=0;d0<2;++d0){s16x4 lo[4],hi[4];
    #pragma unroll
    for(int ks=0;ks<4;++ks){
      asm volatile("ds_read_b64_tr_b16 %0,%1 offset:%c2":"=&v"(lo[ks]):"v"(vb),"i"(d0*4096+ks*1024):"memory");
      asm volatile("ds_read_b64_tr_b16 %0,%1 offset:%c2":"=&v"(hi[ks]):"v"(vb),"i"(d0*4096+ks*1024+512):"memory");}
    asm volatile("s_waitcnt lgkmcnt(0)":::"memory");SBAR();
    #define PK(k) (bf16x8){lo[k][0],lo[k][1],lo[k][2],lo[k][3],hi[k][0],hi[k][1],hi[k][2],hi[k][3]}
    o[d0]=__builtin_amdgcn_mfma_f32_32x32x16_bf16(pa0,PK(0),o[d0],0,0,0);
    o[d0]=__builtin_amdgcn_mfma_f32_32x32x16_bf16(pa1,PK(1),o[d0],0,0,0);
    o[d0]=__builtin_amdgcn_mfma_f32_32x32x16_bf16(pa2,PK(2),o[d0],0,0,0);
    o[d0]=__builtin_amdgcn_mfma_f32_32x32x16_bf16(pa3,PK(3),o[d0],0,0,0);
    #undef PK
  }
}

#ifndef ATTN_STORE16
#define ATTN_STORE16(p,v) (*(u32x4*)(p)=(v))
#endif
constexpr int V_K=0, V_V=NSLOT*SLOTB, V_WS=V_V+NSLOT*2*SLOTB, V_OST=V_WS+NW*64*4, V_LDS_BYTES=V_OST+NW*8192;
#ifndef ATTN_STORE16
#define ATTN_STORE16(p,v) (*(u32x4*)(p)=(v))
#endif
template<int THRL> __device__ __forceinline__ void attn_unit128(int b,int qcol,int vcol,int qb,const bf16*Q,const bf16*__restrict__ K,const bf16*__restrict__ V,bf16*O,char*shm,int mode,float lam,const float*subg){
  int tid_l=threadIdx.x; asm volatile("":"+v"(tid_l)); const int tid=tid_l,lane=tid&63,r32=lane&31,hi=lane>>5; const int wid=__builtin_amdgcn_readfirstlane(tid>>6);
  const long rowbase=(long)b*SEQ; const int q0=qb*QB;
  const bf16*Qw=Q+(rowbase+q0+wid*QBLK)*DM+qcol;
  const bf16*Kh=K+rowbase*DM+qcol,*Vh=V+rowbase*DM+vcol;
  const unsigned lds0=(unsigned)(uintptr_t)shm;
  float*wsf=(float*)(shm+V_WS)+wid*64;
  const bf16*ksrc=Kh+(long)lane*DM+wid*8;
  const bf16*vsrc=Vh+(long)(16*(wid&3)+(lane>>2))*DM+(wid>>2)*32+(lane&3)*8;
  const unsigned kdst=lds0+V_K+wid*1024, vdst=lds0+V_V+wid*1024;
  #define DMA_K(t,slot) glds16(ksrc+(long)(t)*KVBLK*DM,(unsigned)__builtin_amdgcn_readfirstlane(kdst+(slot)))
  #define DMA_V(t,slot) do{ glds16(vsrc+(long)(t)*KVBLK*DM,(unsigned)__builtin_amdgcn_readfirstlane(vdst+2*(slot))); glds16(vsrc+(long)(t)*KVBLK*DM+64,(unsigned)__builtin_amdgcn_readfirstlane(vdst+2*(slot)+8192)); }while(0)
  const int vb0=(int)(lds0+V_V)+((lane>>4)&1)*32+(lane&3)*8+(4*hi+((lane&15)>>2))*64;
  const char*Kbase=shm+V_K; bf16x8 kf[8];
  const lds_cptr shm3=(lds_cptr)shm; const lds_cptr kp0=shm3+V_K+hi*1024+r32*16; const lds_cptr vp0=shm3+V_V+((lane>>4)&1)*32+(lane&3)*8+(4*hi+((lane&15)>>2))*64;
  const int NT=(q0+QB)/KVBLK;
  DMA_K(0,0);DMA_V(0,0);DMA_K(1,SLOTB);
  bf16x8 qr[4];
  #pragma unroll
  for(int d0=0;d0<4;++d0)qr[d0]=*reinterpret_cast<const bf16x8*>(&Qw[(long)r32*DM+d0*16+hi*8]);
  float mhat=0.f,l_reg=0.f;f32x16 o[4];o[0]=f32x16{};o[1]=f32x16{};o[2]=f32x16{};o[3]=f32x16{};f32x16 negm=f32x16{};asm volatile("":"+v"(negm));
  const int qrel=wid*QBLK+r32;
  #define CMASK(P0,P1,t) do{int jb_=(t)-(NT-4); if(jb_>=0)cmask(P0,P1,jb_,qrel,hi);}while(0)
  bool resc=false;
  #define START(P0,P1) do{ const float rm=rowmax(P0,P1); resc=false; \
    { const float dl=rm; mhat=fadd_s(mhat,dl); \
      _Pragma("unroll") for(int r=0;r<16;++r){P0[r]=fsub_s(P0[r],dl);P1[r]=fsub_s(P1[r],dl);} \
      _Pragma("unroll") for(int r=0;r<16;++r)negm[r]=-mhat; asm volatile("":"+v"(negm)); } \
    _Pragma("unroll") for(int r=0;r<16;++r)P0[r]=__builtin_amdgcn_exp2f(P0[r]); }while(0)
  #define RESC() do{ if(resc){ asm volatile("s_waitcnt lgkmcnt(0)":::"memory"); \
      _Pragma("unroll") for(int r=0;r<16;++r){ const float f_=wsf[crow(r,hi)]; o[0][r]*=f_; o[1][r]*=f_; o[2][r]*=f_; o[3][r]*=f_; } } }while(0)
  f32x16 pA0,pA1,pB0,pB1;
  int sl_prev=0,sl_cur=0,sl_next=SLOTB;
  #define ROT() do{sl_prev=sl_cur;sl_cur=sl_next;sl_next=(sl_next==(NSLOT-1)*SLOTB)?0:sl_next+SLOTB;}while(0)
  DMA_K(2,2*SLOTB);
  WAIT_BAR(3);
  qkt(pA0,pA1,Kbase,qr,negm,r32,hi);asm volatile("s_nop 15\n\ts_nop 7":"+v"(pA0),"+v"(pA1));CMASK(pA0,pA1,0);
  START(pA0,pA1);
  _Pragma("unroll") for(int r=0;r<16;++r)pA1[r]=__builtin_amdgcn_exp2f(pA1[r]);
  WAIT_BAR(0);
  DMA_K(3,0);DMA_V(1,SLOTB);
  ROT();
  kload8(kf,kp0+sl_cur);
  WAIT_BAR(3);
  s16x4 vlo[8],vhi[8]; u32x4 pw0,pw1,pw2,pw3;
  #define PKW(P,B) cvtpk_s(P[B],P[B+1])
  #define PAF(k) __builtin_bit_cast(bf16x8,pw##k)
  #define VFR(i) (bf16x8){vlo[i][0],vlo[i][1],vlo[i][2],vlo[i][3],vhi[i][0],vhi[i][1],vhi[i][2],vhi[i][3]}
  #define PIN(x) asm volatile("":"+v"(x))
  #define MX3(a,b,c) __builtin_fmaxf(__builtin_fmaxf((a),(b)),(c))
  #define GAPA(MF,A0,A1,A2,A3,W0,W1,PW) do{ MF; sacc+=A0; sacc+=A1; sacc+=A2; sacc+=A3; PIN(sacc); W0; W1; PIN(PW); SBAR(); }while(0)
  #define EX(v) __builtin_amdgcn_exp2f(v)
  #define GAPB(MF,X,B) do{ MF; X[B]=EX(X[B]); X[B+1]=EX(X[B+1]); PIN(X); SBAR(); }while(0)
  #define VRD(i) do{ vlo[i]=vtr(vp_+(((i)>>2)*4096+((i)&3)*1024)); vhi[i]=vtr(vp_+(((i)>>2)*4096+((i)&3)*1024+512)); }while(0)
  #define VRD2(i) do{ vlo[i]=vtr(vp_+(8192+((i)>>2)*4096+((i)&3)*1024)); vhi[i]=vtr(vp_+(8192+((i)>>2)*4096+((i)&3)*1024+512)); }while(0)
  #define KRD(G,j) do{ if(G){ kload2(kf,kp0+sl_next,j); SBAR(); } }while(0)
  #define STEP(C0,C1,P0,P1,t,GK,GV,GL) do{ SBAR(); \
    const lds_cptr vp_=vp0+2*sl_prev; \
    VRD(0); SBAR(); float sacc=(P0[0]+P0[1]); \
    GAPA(C0=__builtin_amdgcn_mfma_f32_32x32x16_bf16(kf[0],qr[0],negm,0,0,0), P0[2],P0[3],P0[4],P0[5],     pw0[0]=PKW(P0,0), pw0[1]=PKW(P0,2), pw0); \
    VRD(4); SBAR(); GAPA(C1=__builtin_amdgcn_mfma_f32_32x32x16_bf16(kf[1],qr[0],negm,0,0,0), P0[6],P0[7],P0[8],P0[9],     pw0[2]=PKW(P0,4), pw0[3]=PKW(P0,6), pw0); \
    VRD(1); SBAR(); GAPA(C0=__builtin_amdgcn_mfma_f32_32x32x16_bf16(kf[2],qr[1],C0,0,0,0),   P0[10],P0[11],P0[12],P0[13], pw1[0]=PKW(P0,8), pw1[1]=PKW(P0,10), pw1); \
    VRD(5); SBAR(); GAPA(C1=__builtin_amdgcn_mfma_f32_32x32x16_bf16(kf[3],qr[1],C1,0,0,0),   P0[14],P0[15],P1[0],P1[1],   pw1[2]=PKW(P0,12),pw1[3]=PKW(P0,14), pw1); \
    VRD(2); SBAR(); GAPA(C0=__builtin_amdgcn_mfma_f32_32x32x16_bf16(kf[4],qr[2],C0,0,0,0),   P1[2],P1[3],P1[4],P1[5],     pw2[0]=PKW(P1,0), pw2[1]=PKW(P1,2), pw2); \
    VRD(6); SBAR(); GAPA(C1=__builtin_amdgcn_mfma_f32_32x32x16_bf16(kf[5],qr[2],C1,0,0,0),   P1[6],P1[7],P1[8],P1[9],     pw2[2]=PKW(P1,4), pw2[3]=PKW(P1,6), pw2); \
    VRD(3); SBAR(); GAPA(C0=__builtin_amdgcn_mfma_f32_32x32x16_bf16(kf[6],qr[3],C0,0,0,0),   P1[10],P1[11],P1[12],P1[13], pw3[0]=PKW(P1,8), pw3[1]=PKW(P1,10), pw3); \
    VRD(7); SBAR(); GAPA(C1=__builtin_amdgcn_mfma_f32_32x32x16_bf16(kf[7],qr[3],C1,0,0,0),   P1[14],P1[15],0.f,0.f,       pw3[2]=PKW(P1,12),pw3[3]=PKW(P1,14), pw3); \
    l_reg+=sacc; \
    if(GK){DMA_K((t)+3,sl_cur);} if(GV){DMA_V((t)+1,sl_next);} \
    CMASK(C0,C1,t); \
    { float a=MX3(C0[0],C0[1],C1[0]),b=MX3(C0[2],C0[3],C1[1]); a=MX3(a,C1[2],C1[3]); \
      _Pragma("unroll") for(int r=4;r<16;r+=4){a=MX3(a,C0[r],C0[r+1]);b=MX3(b,C0[r+2],C0[r+3]);a=MX3(a,C1[r],C1[r+1]);b=MX3(b,C1[r+2],C1[r+3]);} \
      float rm=__builtin_fmaxf(a,b); { auto rr=__builtin_amdgcn_permlane32_swap(__float_as_uint(rm),__float_as_uint(rm),false,false); rm=__builtin_fmaxf(__uint_as_float(rr[0]),__uint_as_float(rr[1])); } \
      resc=false; \
      if(__builtin_expect(__any(rm>(float)THRL),0)){ const float dl=__builtin_fmaxf(rm,0.f); mhat+=dl; \
        _Pragma("unroll") for(int r=0;r<16;++r){C0[r]-=dl;C1[r]-=dl;} \
        _Pragma("unroll") for(int r=0;r<16;++r)negm[r]=-mhat; asm volatile("":"+v"(negm)); \
        const float f=__builtin_amdgcn_exp2f(-dl); l_reg*=f; if(hi==0)wsf[r32]=f; resc=true; } } \
    SBAR(); \
    GAPB(o[0]=__builtin_amdgcn_mfma_f32_32x32x16_bf16(PAF(0),VFR(0),o[0],0,0,0), C0,0);  VRD2(0); SBAR(); \
    GAPB(o[1]=__builtin_amdgcn_mfma_f32_32x32x16_bf16(PAF(0),VFR(4),o[1],0,0,0), C0,2);  VRD2(4); SBAR(); \
    GAPB(o[0]=__builtin_amdgcn_mfma_f32_32x32x16_bf16(PAF(1),VFR(1),o[0],0,0,0), C0,4);  VRD2(1); SBAR(); \
    GAPB(o[1]=__builtin_amdgcn_mfma_f32_32x32x16_bf16(PAF(1),VFR(5),o[1],0,0,0), C0,6);  VRD2(5); SBAR(); \
    GAPB(o[0]=__builtin_amdgcn_mfma_f32_32x32x16_bf16(PAF(2),VFR(2),o[0],0,0,0), C0,8);  VRD2(2); SBAR(); \
    GAPB(o[1]=__builtin_amdgcn_mfma_f32_32x32x16_bf16(PAF(2),VFR(6),o[1],0,0,0), C0,10); VRD2(6); SBAR(); \
    GAPB(o[0]=__builtin_amdgcn_mfma_f32_32x32x16_bf16(PAF(3),VFR(3),o[0],0,0,0), C0,12); VRD2(3); SBAR(); \
    GAPB(o[1]=__builtin_amdgcn_mfma_f32_32x32x16_bf16(PAF(3),VFR(7),o[1],0,0,0), C0,14); VRD2(7); SBAR(); \
    GAPB(o[2]=__builtin_amdgcn_mfma_f32_32x32x16_bf16(PAF(0),VFR(0),o[2],0,0,0), C1,0); \
    GAPB(o[3]=__builtin_amdgcn_mfma_f32_32x32x16_bf16(PAF(0),VFR(4),o[3],0,0,0), C1,2); \
    KRD(GL,0); GAPB(o[2]=__builtin_amdgcn_mfma_f32_32x32x16_bf16(PAF(1),VFR(1),o[2],0,0,0), C1,4); \
    KRD(GL,1); GAPB(o[3]=__builtin_amdgcn_mfma_f32_32x32x16_bf16(PAF(1),VFR(5),o[3],0,0,0), C1,6); \
    KRD(GL,2); GAPB(o[2]=__builtin_amdgcn_mfma_f32_32x32x16_bf16(PAF(2),VFR(2),o[2],0,0,0), C1,8); \
    KRD(GL,3); GAPB(o[3]=__builtin_amdgcn_mfma_f32_32x32x16_bf16(PAF(2),VFR(6),o[3],0,0,0), C1,10); \
    GAPB(o[2]=__builtin_amdgcn_mfma_f32_32x32x16_bf16(PAF(3),VFR(3),o[2],0,0,0), C1,12); \
    GAPB(o[3]=__builtin_amdgcn_mfma_f32_32x32x16_bf16(PAF(3),VFR(7),o[3],0,0,0), C1,14); \
    }while(0)
  int t=1;
  #undef CMASK
  #define CMASK(P0,P1,t) do{}while(0)
  for(;t+5<NT;t+=2){
    STEP(pB0,pB1,pA0,pA1,t,true,true,true);     WAIT_BAR(3); RESC(); ROT();
    STEP(pA0,pA1,pB0,pB1,t+1,true,true,true);   WAIT_BAR(3); RESC(); ROT();
  }
  #undef CMASK
  #define CMASK(P0,P1,t) do{int jb_=(t)-(NT-4); if(jb_>=0)cmask(P0,P1,jb_,qrel,hi);}while(0)
  #define ENDW(tt) do{ if((tt)+3<NT){WAIT_BAR(3);} else if((tt)+2<NT){WAIT_BAR(2);} else {WAIT_BAR(0);} }while(0)
  for(;t+1<NT;t+=2){
    STEP(pB0,pB1,pA0,pA1,t,(t+3<NT),(t+1<NT),(t+1<NT));       ENDW(t);   RESC(); ROT();
    STEP(pA0,pA1,pB0,pB1,t+1,(t+4<NT),(t+2<NT),(t+2<NT));     ENDW(t+1); RESC(); ROT();
  }
  STEP(pB0,pB1,pA0,pA1,NT-1,false,false,false); RESC();
  { float sacc=pB0[0]+pB0[1]; _Pragma("unroll") for(int r=2;r<16;++r)sacc+=pB0[r]; _Pragma("unroll") for(int r=0;r<16;++r)sacc+=pB1[r]; l_reg+=sacc;
    pw0=(u32x4){PKW(pB0,0),PKW(pB0,2),PKW(pB0,4),PKW(pB0,6)};pw1=(u32x4){PKW(pB0,8),PKW(pB0,10),PKW(pB0,12),PKW(pB0,14)};pw2=(u32x4){PKW(pB1,0),PKW(pB1,2),PKW(pB1,4),PKW(pB1,6)};pw3=(u32x4){PKW(pB1,8),PKW(pB1,10),PKW(pB1,12),PKW(pB1,14)};
    SBAR(); pv(o,vb0+2*sl_cur,PAF(0),PAF(1),PAF(2),PAF(3)); pv(o+2,vb0+2*sl_cur+8192,PAF(0),PAF(1),PAF(2),PAF(3)); }
  #undef PKW
  #undef PAF
  #undef VFR
  #undef PIN
  #undef MX3
  #undef GAPA
  #undef GAPB
  #undef EX
  #undef VRD
  #undef VRD2
  #undef KRD
  #undef STEP
  #undef ENDW
  {auto rr=__builtin_amdgcn_permlane32_swap(__float_as_uint(l_reg),__float_as_uint(l_reg),false,false);l_reg=__uint_as_float(rr[0])+__uint_as_float(rr[1]);}
  if(hi==0)wsf[32+r32]=l_reg;asm volatile("s_waitcnt lgkmcnt(0)":::"memory");
  float rli[16];
  #pragma unroll
  for(int r=0;r<16;++r)rli[r]=__builtin_amdgcn_rcpf(wsf[32+crow(r,hi)]);
  bf16*Ow=O+(rowbase+q0+wid*QBLK)*DM+vcol;
  { unsigned short*stash=(unsigned short*)(shm+V_OST)+wid*4096;
    if(mode==0){
      #pragma unroll
      for(int r=0;r<16;++r){const int orow=crow(r,hi);
        #pragma unroll
        for(int q=0;q<4;++q)stash[orow*128+q*32+r32]=(unsigned short)(cvtpk_s(o[q][r]*rli[r],0.f)&0xffffu);}
    } else {
      #pragma unroll
      for(int r=0;r<16;++r){const int orow=crow(r,hi);
        #pragma unroll
        for(int q=0;q<4;++q){ const float a=__uint_as_float((unsigned)stash[orow*128+q*32+r32]<<16); const float d=a-lam*(o[q][r]*rli[r]); stash[orow*128+q*32+r32]=(unsigned short)(cvtpk_s(d,0.f)&0xffffu);} }
      asm volatile("s_waitcnt lgkmcnt(0)":::"memory");
      const int row=lane>>1,hf=lane&1; const unsigned short*rp=stash+row*128+hf*64;
      u32x4 v[8]; float ss=0.f;
      #pragma unroll
      for(int i=0;i<8;++i){ v[i]=*(const u32x4*)(rp+i*8);
        const float e0=__uint_as_float(v[i].x<<16),e1=__uint_as_float(v[i].x&0xffff0000u),e2=__uint_as_float(v[i].y<<16),e3=__uint_as_float(v[i].y&0xffff0000u),e4=__uint_as_float(v[i].z<<16),e5=__uint_as_float(v[i].z&0xffff0000u),e6=__uint_as_float(v[i].w<<16),e7=__uint_as_float(v[i].w&0xffff0000u);
        ss+=(e0*e0+e1*e1)+(e2*e2+e3*e3)+(e4*e4+e5*e5)+(e6*e6+e7*e7); }
      ss+=__shfl_xor(ss,1);
      const float rsn=__builtin_amdgcn_rsqf(ss*(1.f/128.f)+1e-5f)*0.8f;
      bf16*orow_p=Ow+(long)row*DM+hf*64;
      #pragma unroll
      for(int i=0;i<8;++i){ const float*gp=subg+hf*64+i*8; const float g0=gp[0],g1=gp[1],g2=gp[2],g3=gp[3],g4=gp[4],g5=gp[5],g6=gp[6],g7=gp[7];
        u32x4 w; w.x=cvtpk_s(__uint_as_float(v[i].x<<16)*rsn*g0,__uint_as_float(v[i].x&0xffff0000u)*rsn*g1); w.y=cvtpk_s(__uint_as_float(v[i].y<<16)*rsn*g2,__uint_as_float(v[i].y&0xffff0000u)*rsn*g3);
        w.z=cvtpk_s(__uint_as_float(v[i].z<<16)*rsn*g4,__uint_as_float(v[i].z&0xffff0000u)*rsn*g5); w.w=cvtpk_s(__uint_as_float(v[i].w<<16)*rsn*g6,__uint_as_float(v[i].w&0xffff0000u)*rsn*g7);
        ATTN_STORE16(orow_p+i*8,w); }
    } }
  asm volatile("s_waitcnt lgkmcnt(0)\n\ts_barrier":::"memory");
  #undef DMA_K
  #undef DMA_V
  #undef CMASK
  #undef START
  #undef RESC
  #undef ROT
}
constexpr int ATTN_LDS_BYTES=LDS_BYTES;
struct AttnTensors { const bf16* Q; const bf16* K; const bf16* V; bf16* Y; const float* lq1; const float* lk1; const float* lq2; const float* lk2; const float* subg; };
struct AttnUnit { int bh; int qb; };
constexpr int NBH=32;
struct StaticOrder {
  int vcu,G;
  __device__ __forceinline__ explicit StaticOrder(int grid,int block):vcu((grid%8==0)?(block%8)*(grid/8)+block/8:block),G(grid){}
  __device__ __forceinline__ bool next(int i,AttnUnit&u)const{
    if(G==256){ if(i>=4)return false; const int s=vcu&7; u.bh=vcu>>3; u.qb=(i==0)?s:(i==1)?15-s:(i==2)?16+s:31-s; return true; }
    const int L=i*G+vcu; if(L>=NBH*NQB)return false; u.bh=L/NQB; u.qb=NQB-1-(L%NQB); return true; }
};
template<class Sched,int THRL=8> __device__ __forceinline__ void attn_phase(char*lds,const AttnTensors&T,const Sched&S){
  float lam;
  { const int l_=threadIdx.x&63; float a=T.lq1[l_]*T.lk1[l_],b2=T.lq2[l_]*T.lk2[l_];
    #pragma unroll
    for(int o_=1;o_<64;o_<<=1){a+=__shfl_xor(a,o_);b2+=__shfl_xor(b2,o_);}
    lam=__expf(a)-__expf(b2)+0.2f; }
  AttnUnit u;
  for(int i=0;S.next(i,u);++i){ const int h=u.bh&7,b=u.bh>>3;
    #pragma unroll 1
    for(int map=0;map<2;++map) attn_unit128<THRL>(b,h*128+map*64,h*128,u.qb,T.Q,T.K,T.V,T.Y,lds,map,lam,T.subg); }
}
#undef SBAR
#undef WAIT_BAR
}
#define GAS __attribute__((address_space(1)))
#define LAS __attribute__((address_space(3)))
typedef unsigned short bf16;
typedef unsigned v4u __attribute__((ext_vector_type(4)));
typedef float f32x4 __attribute__((ext_vector_type(4)));
typedef float f32x16 __attribute__((ext_vector_type(16)));
typedef short bf16x8 __attribute__((ext_vector_type(8)));
using pg8::sigmoidf_fast; using pg8::gelu_tanh;
constexpr int NWAVES = 8, NTHR = 512;
constexpr int BATCH = 4, SEQ = 8192, DM = 1024, M = BATCH * SEQ, DIN = 7 * DM, DFF = 3 * DM;
constexpr float EPS = 1e-6f;
constexpr size_t MiB = 1u << 20;
constexpr size_t WS_SS = 0, WS_SS2 = 512 * 1024;
constexpr size_t WS_BAR = 768 * 1024;
constexpr size_t WS_PCNT = WS_BAR + 16 * 1024, WS_ZERO_BYTES = 16 * 1024 + 128 * 64 * 4;
constexpr size_t WS_SUM = 1 * MiB;
constexpr size_t WS_WIN = 2 * MiB, WS_WUP = 16 * MiB, WS_WDN = 28 * MiB, WS_PA = 34 * MiB, WS_PB = 36 * MiB, WS_WO = 38 * MiB, WS_WG = 40 * MiB;
constexpr size_t WS_S0 = 48 * MiB, SLOT = 64 * MiB;
constexpr size_t WS_NEED = WS_S0 + 7 * SLOT;
constexpr int RING_BYTES = 131072, LDS_BYTES = 159744, LDS_BARST = LDS_BYTES - 16;

__device__ __forceinline__ unsigned f2bf(float f) { unsigned u = __builtin_bit_cast(unsigned, f); return (u + 0x7fffu + ((u >> 16) & 1u)) >> 16; }
__device__ __forceinline__ unsigned pk2(float lo, float hi) { return f2bf(lo) | (f2bf(hi) << 16); }
__device__ __forceinline__ float bflo(unsigned w) { return __uint_as_float(w << 16); }
__device__ __forceinline__ float bfhi(unsigned w) { return __uint_as_float(w & 0xffff0000u); }
__device__ __forceinline__ float wave_sum(float v) {
#pragma unroll
    for (int o = 1; o < 64; o <<= 1) v += __shfl_xor(v, o);
    return v;
}
#define LDS_WAIT() asm volatile("s_waitcnt lgkmcnt(0)" ::: "memory")

__device__ __forceinline__ void p0_transpose_item(const float* W, int K, int N, bf16* WT, int row_off, LAS float* scr, int item, int lane, const float* kscale, bool gv_interleave = false) {
    const int nblk = N / 32, kb = item / nblk, nb = item % nblk, k0 = 64 * kb, n0 = 32 * nb;
    int no = n0; if (gv_interleave) { const int hf = N / 2, c = (n0 < hf) ? n0 : n0 - hf; no = (c >> 7) * 256 + ((n0 < hf) ? 0 : 128) + (c & 127); }
#pragma unroll
    for (int i = 0; i < 32; ++i) { const int kk = 2 * i + (lane >> 5); float w = W[(size_t)(k0 + kk) * N + n0 + (lane & 31)]; if (kscale) w *= kscale[k0 + kk]; scr[kk * 33 + (lane & 31)] = w; }
    LDS_WAIT(); asm volatile("" ::: "memory");
    const int c = lane & 7;
#pragma unroll
    for (int j = 0; j < 4; ++j) { const int n = (lane >> 3) + 8 * j; const LAS float* s = scr + (8 * c) * 33 + n;
        v4u o; o.x = pk2(s[0 * 33], s[1 * 33]); o.y = pk2(s[2 * 33], s[3 * 33]); o.z = pk2(s[4 * 33], s[5 * 33]); o.w = pk2(s[6 * 33], s[7 * 33]);
        *(v4u*)(WT + (size_t)(row_off + no + n) * K + k0 + 8 * c) = o; }
    LDS_WAIT(); asm volatile("" ::: "memory");
}

#define RLX_AGENT __ATOMIC_RELAXED, __HIP_MEMORY_SCOPE_AGENT
#define XB_TMO      128
#define XB_XCNT(j)  (256  + 64 * (j))
#define XB_XSUB(j)  (1280 + 64 * (j))
#define XB_XGEN(j)  (2304 + 64 * (j))
#define XB_TOP      3328
#define XB_TOPGEN   3392
#define XCD_BAR_WORDS 3456
#define XB_SPIN_CAP (1u << 18)

__device__ __forceinline__ unsigned xb_ld(unsigned* p)              { return __hip_atomic_load(p, __ATOMIC_RELAXED, __HIP_MEMORY_SCOPE_AGENT); }
__device__ __forceinline__ unsigned xb_add(unsigned* p, unsigned v) { return __hip_atomic_fetch_add(p, v, __ATOMIC_RELAXED, __HIP_MEMORY_SCOPE_AGENT); }
__device__ __forceinline__ unsigned xb_xcc_id() { return (unsigned)__builtin_amdgcn_s_getreg((3 << 11) | 20) & 0xFu; }
#define XB_SPIN(cond, bar) do { unsigned _sp = 0; while (cond) { __builtin_amdgcn_s_sleep(1); \
    if ((++_sp & 255u) == 0u) { if (xb_ld(&(bar)[XB_TMO])) break; if (_sp > XB_SPIN_CAP) { atomicAdd(&(bar)[XB_TMO], 1u); break; } } } } while (0)

struct XcdBarrier {
    unsigned* bar; unsigned x;
    volatile LAS unsigned* st;
};

__device__ __forceinline__ XcdBarrier xcd_barrier_post(unsigned* bar, volatile LAS unsigned* st) {
    XcdBarrier b; b.bar = bar; b.x = xb_xcc_id(); b.st = st;
    if (threadIdx.x == 0) (void)xb_add(&bar[XB_XCNT(b.x)], 1u);
    return b;
}
__device__ __forceinline__ void xcd_barrier_complete(unsigned* bar, unsigned x, unsigned& nloc, unsigned& nx) {
    const unsigned G = gridDim.x * gridDim.y * gridDim.z;
    unsigned sum, cnt, mine, sp = 0u;
    for (;;) {
        sum = 0u; cnt = 0u; mine = 0u;
#pragma unroll
        for (unsigned j = 0; j < 16; ++j) { const unsigned c = xb_ld(&bar[XB_XCNT(j)]); sum += c; cnt += (c > 0u) ? 1u : 0u; mine = (j == x) ? c : mine; }
        if (sum == G) break;
        __builtin_amdgcn_s_sleep(1);
        if ((++sp & 255u) == 0u) { if (xb_ld(&bar[XB_TMO])) break; if (sp > XB_SPIN_CAP) { atomicAdd(&bar[XB_TMO], 1u); break; } }
    }
    nloc = mine > 0u ? mine : 1u; nx = cnt > 0u ? cnt : 1u;
}

__device__ __forceinline__ void xcd_barrier(const XcdBarrier& b) {
    asm volatile("s_waitcnt vmcnt(0)" ::: "memory");
    __syncthreads();
    if (threadIdx.x == 0) {
        unsigned* bar = b.bar;
        __builtin_amdgcn_s_waitcnt(0);
        unsigned nloc = b.st[0], nx = b.st[1];
        if (nloc == 0u) { xcd_barrier_complete(bar, b.x, nloc, nx); b.st[0] = nloc; b.st[1] = nx; }
        const unsigned old = xb_add(&bar[XB_XSUB(b.x)], 1u);
        const unsigned gen = old / nloc;
        if (old + 1u == (gen + 1u) * nloc) {
            __builtin_amdgcn_fence(__ATOMIC_RELEASE, "agent");
            asm volatile("s_waitcnt vmcnt(0)" ::: "memory");
            const unsigned og = xb_add(&bar[XB_TOP], 1u);
            const unsigned tg = og / nx;
            if (og + 1u == (tg + 1u) * nx) xb_add(&bar[XB_TOPGEN], 1u);
            else XB_SPIN(xb_ld(&bar[XB_TOPGEN]) == tg, bar);
            __builtin_amdgcn_fence(__ATOMIC_ACQUIRE, "agent");
            xb_add(&bar[XB_XGEN(b.x)], 1u);
            asm volatile("s_waitcnt vmcnt(0)" ::: "memory");
        } else {
            XB_SPIN(xb_ld(&bar[XB_XGEN(b.x)]) == gen, bar);
            __builtin_amdgcn_fence(__ATOMIC_ACQUIRE, "agent");
            asm volatile("s_waitcnt vmcnt(0)" ::: "memory");
        }
    }
    __syncthreads();
}

typedef float f32x2v __attribute__((ext_vector_type(2)));
constexpr int XC_PITCH = 264;
__device__ __forceinline__ int crow16(int r, int hi) { return (r & 3) + 8 * (r >> 2) + 4 * hi; }
template <int MODE>
__device__ __forceinline__ void rnn_unit(LAS unsigned char* lds, int tile, int cpair, const bf16* XR, const bf16* GR, bf16* YR, const bf16* WG, float* SUMM,
                                         const float* conv_w, const float* conv_b, const float* ba, const float* bx, const float* lam) {
    int tid_l = threadIdx.x; asm volatile("" : "+v"(tid_l));
    const int tid = tid_l, lane = tid & 63, w = __builtin_amdgcn_readfirstlane(tid >> 6), j = lane & 31, hi = lane >> 5;
    const int tb = tile & 31;
    const size_t R0 = (size_t)tile * 256;
    const int c0 = cpair * 256;
    LAS bf16* XC = (LAS bf16*)lds;
    {
        const int chunk = tid & 31, rg = tid >> 5, cc = c0 + chunk * 8;
        float wk[4][8], bb[8];
#pragma unroll
        for (int k = 0; k < 4; ++k) { const f32x4 a = *(const f32x4*)(conv_w + k * 1024 + cc), b = *(const f32x4*)(conv_w + k * 1024 + cc + 4);
            wk[k][0] = a[0]; wk[k][1] = a[1]; wk[k][2] = a[2]; wk[k][3] = a[3]; wk[k][4] = b[0]; wk[k][5] = b[1]; wk[k][6] = b[2]; wk[k][7] = b[3]; }
        { const f32x4 a = *(const f32x4*)(conv_b + cc), b = *(const f32x4*)(conv_b + cc + 4); bb[0] = a[0]; bb[1] = a[1]; bb[2] = a[2]; bb[3] = a[3]; bb[4] = b[0]; bb[5] = b[1]; bb[6] = b[2]; bb[7] = b[3]; }
        float win[3][8];
        const int r0 = rg * 16;
#pragma unroll
        for (int q = 0; q < 3; ++q) { const int r = r0 - 3 + q; v4u v = (v4u){0u, 0u, 0u, 0u};
            if (r >= 0 || tb > 0) v = *(const v4u*)(XR + (size_t)((long)R0 + r) * 1024 + cc);
            win[q][0] = bflo(v.x); win[q][1] = bfhi(v.x); win[q][2] = bflo(v.y); win[q][3] = bfhi(v.y); win[q][4] = bflo(v.z); win[q][5] = bfhi(v.z); win[q][6] = bflo(v.w); win[q][7] = bfhi(v.w); }
#pragma unroll
        for (int i = 0; i < 16; ++i) { const int r = r0 + i; const v4u v = *(const v4u*)(XR + (R0 + r) * 1024 + cc);
            float cur[8] = {bflo(v.x), bfhi(v.x), bflo(v.y), bfhi(v.y), bflo(v.z), bfhi(v.z), bflo(v.w), bfhi(v.w)};
            float o[8];
#pragma unroll
            for (int e = 0; e < 8; ++e) o[e] = bb[e] + wk[0][e] * win[0][e] + wk[1][e] * win[1][e] + wk[2][e] * win[2][e] + wk[3][e] * cur[e];
            v4u ov; ov.x = pk2(o[0], o[1]); ov.y = pk2(o[2], o[3]); ov.z = pk2(o[4], o[5]); ov.w = pk2(o[6], o[7]);
            *(LAS v4u*)(XC + r * XC_PITCH + chunk * 8) = ov;
#pragma unroll
            for (int e = 0; e < 8; ++e) { win[0][e] = win[1][e]; win[1][e] = win[2][e]; win[2][e] = cur[e]; } }
    }
    __syncthreads();
    const int ch = c0 + w * 32 + j;
    const int nblk = ch >> 7, jb = ch & 127;
    bf16x8 BR[8], BI[8];
#pragma unroll
    for (int ks = 0; ks < 8; ++ks) { BR[ks] = *(const bf16x8*)(WG + ((size_t)nblk * 256 + jb) * 128 + ks * 16 + hi * 8); BI[ks] = *(const bf16x8*)(WG + ((size_t)nblk * 256 + 128 + jb) * 128 + ks * 16 + hi * 8); }
    const float bav = ba[ch], bxv = bx[ch];
    const float lm = lam[ch];
    const float sp = (lm > 15.f) ? __expf(-lm) : log1pf(__expf(-lm));
    const float c8l2 = -8.0f * 1.4426950408889634f * sp;
    float h = 0.f, Atot = 1.f;
    if (MODE == 1) { const float* sb = SUMM + (size_t)(tile - tb) * 2048 + ch;
        for (int q0 = 0; q0 < tb; q0 += 8) { float A_[8], B_[8];
#pragma unroll
            for (int e = 0; e < 8; ++e) { const int q = (q0 + e < tb) ? q0 + e : tb - 1; A_[e] = sb[(size_t)q * 2048]; B_[e] = sb[(size_t)q * 2048 + 1024]; }
#pragma unroll
            for (int e = 0; e < 8; ++e) if (q0 + e < tb) h = A_[e] * h + B_[e]; } }
    const int kcol = (w >> 2) * 128;
    const bf16* grb = GR + (R0 + 4 * hi) * 1024 + ch; bf16* yrb = YR + (R0 + 4 * hi) * 1024 + ch;
    const float NL = -1.4426950408889634f; const f32x2v nbr = (f32x2v){NL * bav, NL * bav}, nbi = (f32x2v){NL * bxv, NL * bxv};
    LAS unsigned char* T = lds + 256 * XC_PITCH * 2 + w * 2560; const int prow = lane >> 2, pch = lane & 3;
    const bf16* grp = GR + (R0 + prow) * 1024 + c0 + w * 32 + pch * 8; bf16* ypp = YR + (R0 + prow) * 1024 + c0 + w * 32 + pch * 8;
#pragma unroll 1
    for (int t32 = 0; t32 < 8; ++t32) {
        f32x16 aR, aI;
        unsigned short grv[16]; v4u gq0 = (v4u){0u, 0u, 0u, 0u}, gq1 = gq0;
        if (MODE == 1) { gq0 = *(const v4u*)(grp + (size_t)(t32 * 32) * 1024); gq1 = *(const v4u*)(grp + (size_t)(t32 * 32 + 16) * 1024); }
#pragma unroll
        for (int r = 0; r < 16; ++r) { aR[r] = 0.f; aI[r] = 0.f; }
        const LAS bf16* arow = XC + (t32 * 32 + j) * XC_PITCH + kcol + hi * 8;
#pragma unroll
        for (int ks = 0; ks < 8; ++ks) { const bf16x8 a = *(const LAS bf16x8*)(arow + ks * 16);
            aR = __builtin_amdgcn_mfma_f32_32x32x16_bf16(a, BR[ks], aR, 0, 0, 0); aI = __builtin_amdgcn_mfma_f32_32x32x16_bf16(a, BI[ks], aI, 0, 0, 0); }
        float av[16], bv[16];
        const LAS bf16* xcol = XC + (t32 * 32 + 4 * hi) * XC_PITCH + w * 32 + j;
#pragma unroll
        for (int r = 0; r < 16; r += 2) { const int ro = (r & 3) + 8 * (r >> 2);
            const f32x2v x2 = (f32x2v){__uint_as_float((unsigned)xcol[ro * XC_PITCH] << 16), __uint_as_float((unsigned)xcol[(ro + 1) * XC_PITCH] << 16)};
            f32x2v er = (f32x2v){aR[r], aR[r + 1]} * NL + nbr, ei = (f32x2v){aI[r], aI[r + 1]} * NL + nbi;
            er.x = __builtin_amdgcn_exp2f(er.x); er.y = __builtin_amdgcn_exp2f(er.y); ei.x = __builtin_amdgcn_exp2f(ei.x); ei.y = __builtin_amdgcn_exp2f(ei.y);
            er = er + 1.0f; ei = ei + 1.0f;
            f32x2v rg; rg.x = __builtin_amdgcn_rcpf(er.x); rg.y = __builtin_amdgcn_rcpf(er.y);
            f32x2v a2 = rg * c8l2; a2.x = __builtin_amdgcn_exp2f(a2.x); a2.y = __builtin_amdgcn_exp2f(a2.y);
            f32x2v om = 1.0f - a2 * a2; om.x = fmaxf(om.x, 1e-30f); om.y = fmaxf(om.y, 1e-30f);
            f32x2v q2 = om * ei * ei; q2.x = __builtin_amdgcn_rsqf(q2.x); q2.y = __builtin_amdgcn_rsqf(q2.y);
            const f32x2v b2 = om * q2 * x2;
            av[r] = a2.x; av[r + 1] = a2.y; bv[r] = b2.x; bv[r + 1] = b2.y; }
        float Ag[4], Bg[4], pA[4], pB[4], hs[4];
#pragma unroll
        for (int g = 0; g < 4; ++g) { float A = av[4 * g], B = bv[4 * g];
#pragma unroll
            for (int e = 1; e < 4; ++e) { B = av[4 * g + e] * B + bv[4 * g + e]; A *= av[4 * g + e]; }
            Ag[g] = A; Bg[g] = B; pA[g] = __shfl_xor(A, 32); pB[g] = __shfl_xor(B, 32); }
        float hrun = h;
#pragma unroll
        for (int g = 0; g < 4; ++g) { const float loA = hi ? pA[g] : Ag[g], loB = hi ? pB[g] : Bg[g], hiA = hi ? Ag[g] : pA[g], hiB = hi ? Bg[g] : pB[g];
            const float hmid = loA * hrun + loB; hs[g] = hi ? hmid : hrun; hrun = hiA * hmid + hiB; if (MODE == 0) Atot *= loA * hiA; }
        h = hrun;
        if (MODE == 1) {
            *(LAS v4u*)(T + prow * 80 + pch * 16) = gq0; *(LAS v4u*)(T + (prow + 16) * 80 + pch * 16) = gq1;
            asm volatile("" ::: "memory");
#pragma unroll
            for (int r = 0; r < 16; ++r) grv[r] = *(const LAS unsigned short*)(T + (crow16(r, hi)) * 80 + j * 2);
            asm volatile("" ::: "memory");
#pragma unroll
            for (int g = 0; g < 4; ++g) { float hh = hs[g]; float yv[4];
#pragma unroll
                for (int e = 0; e < 4; ++e) { const int r = 4 * g + e; hh = av[r] * hh + bv[r]; yv[e] = hh * gelu_tanh(__uint_as_float((unsigned)grv[r] << 16)); }
                const unsigned p01 = pg8::cvt_pk_bf16(yv[0], yv[1]), p23 = pg8::cvt_pk_bf16(yv[2], yv[3]);
                LAS unsigned short* tp = (LAS unsigned short*)(T + (8 * g + 4 * hi) * 80 + j * 2);
                tp[0] = (unsigned short)(p01 & 0xffffu); tp[40] = (unsigned short)(p01 >> 16); tp[80] = (unsigned short)(p23 & 0xffffu); tp[120] = (unsigned short)(p23 >> 16); }
            asm volatile("" ::: "memory");
            const v4u y0 = *(const LAS v4u*)(T + prow * 80 + pch * 16), y1 = *(const LAS v4u*)(T + (prow + 16) * 80 + pch * 16);
            *(v4u*)(ypp + (size_t)(t32 * 32) * 1024) = y0; *(v4u*)(ypp + (size_t)(t32 * 32 + 16) * 1024) = y1;
            asm volatile("" ::: "memory");
        }
    }
    if (MODE == 0 && hi == 0) { SUMM[(size_t)tile * 2048 + ch] = Atot; SUMM[(size_t)tile * 2048 + 1024 + ch] = h; }
    __syncthreads();
}

struct Args { const float* in[24]; float* out; unsigned char* ws; };
__global__ void __launch_bounds__(NTHR, 2) fwd_megakernel(Args args) {
    extern __shared__ __attribute__((aligned(16))) unsigned char lds[];
    cg::grid_group grid = cg::this_grid();
    LAS unsigned char* L = (LAS unsigned char*)lds;
    if (threadIdx.x < 4) ((LAS unsigned*)(L + LDS_BARST))[threadIdx.x] = 0u;
    __syncthreads();
    const int G = gridDim.x, bx = blockIdx.x;
    const int vcu = (G % 8 == 0) ? (bx % 8) * (G / 8) + bx / 8 : bx;
    const int NGW = G * NWAVES;
#define PHASE_IDS() int tid_l = threadIdx.x; asm volatile("" : "+v"(tid_l)); const int tid = tid_l, lane = tid & 63, wave = __builtin_amdgcn_readfirstlane(tid >> 6), gw = vcu * NWAVES + wave; (void)lane; (void)gw
    unsigned char* ws = args.ws;
    const XcdBarrier xbar = xcd_barrier_post((unsigned*)(ws + WS_BAR), (volatile LAS unsigned*)(L + LDS_BARST));
    const float* x = args.in[0];
    float* out = args.out;
    float* SS = (float*)(ws + WS_SS); float* SS2 = (float*)(ws + WS_SS2); float* SUMM = (float*)(ws + WS_SUM);
    bf16 *WinT = (bf16*)(ws + WS_WIN), *WupT = (bf16*)(ws + WS_WUP), *WdnT = (bf16*)(ws + WS_WDN), *PAT = (bf16*)(ws + WS_PA), *PBT = (bf16*)(ws + WS_PB), *WoT = (bf16*)(ws + WS_WO), *WG = (bf16*)(ws + WS_WG);
    bf16* S0 = (bf16*)(ws + WS_S0);
#define SLOTP(i) ((bf16*)(ws + WS_S0 + (size_t)(i) * SLOT))
    bf16 *XR = SLOTP(0), *GRb = SLOTP(1), *Qb = SLOTP(2), *Kb = SLOTP(3), *Vb = SLOTP(4), *GRNN = SLOTP(5), *GATT = SLOTP(6);
    bf16 *XN = (bf16*)out, *YATT = (bf16*)out + (size_t)M * DM;
    bf16 *YRNN = SLOTP(2); bf16* MERGED = SLOTP(0);
    bf16 *X1B = SLOTP(6), *X2B = SLOTP(5), *ACT = SLOTP(0), *SG = SLOTP(3), *SV = SLOTP(4);

    {
        PHASE_IDS();
        LAS float* scr = (LAS float*)(L + wave * 16384);
        constexpr int I_IN = 16 * (DIN / 32), I_UP = 16 * (2 * DFF / 32), I_DN = (DFF / 64) * 32, I_SQ = 16 * 32;
        constexpr int NITEMS = I_IN + I_UP + I_DN + 3 * I_SQ;
        struct TItem { const float* W; bf16* WT; const float* ks; int K, N, k0, n0, no; };
        auto decode = [&](int it) -> TItem {
            TItem t; int r = it; bool gvi = false;
            if (r < I_IN) { t.W = args.in[2]; t.K = DM; t.N = DIN; t.WT = WinT; t.ks = nullptr; }
            else if ((r -= I_IN) < I_UP) { t.W = args.in[19]; t.K = DM; t.N = 2 * DFF; t.WT = WupT; t.ks = args.in[18]; gvi = true; }
            else if ((r -= I_UP) < I_DN) { t.W = args.in[22]; t.K = DFF; t.N = DM; t.WT = WdnT; t.ks = nullptr; }
            else if ((r -= I_DN) < I_SQ) { t.W = args.in[15]; t.K = DM; t.N = DM; t.WT = PAT; t.ks = nullptr; }
            else if ((r -= I_SQ) < I_SQ) { t.W = args.in[16]; t.K = DM; t.N = DM; t.WT = PBT; t.ks = nullptr; }
            else { r -= I_SQ; t.W = args.in[17]; t.K = DM; t.N = DM; t.WT = WoT; t.ks = nullptr; }
            const int nblk = t.N / 32, kb = r / nblk, nb = r % nblk; t.k0 = 64 * kb; t.n0 = 32 * nb; t.no = t.n0;
            if (gvi) { const int hf = t.N / 2, c = (t.n0 < hf) ? t.n0 : t.n0 - hf; t.no = (c >> 7) * 256 + ((t.n0 < hf) ? 0 : 128) + (c & 127); }
            return t; };
        float wv[32], wn[32];
        int it = gw;
        TItem cur = decode(it < NITEMS ? it : 0);
        if (it < NITEMS) {
#pragma unroll
            for (int i = 0; i < 32; ++i) wv[i] = cur.W[(size_t)(cur.k0 + 2 * i + (lane >> 5)) * cur.N + cur.n0 + (lane & 31)]; }
        while (it < NITEMS) {
            const int itn = it + NGW; const bool hn = itn < NITEMS;
            const TItem nxt = decode(hn ? itn : it);
            if (hn) {
#pragma unroll
                for (int i = 0; i < 32; ++i) wn[i] = nxt.W[(size_t)(nxt.k0 + 2 * i + (lane >> 5)) * nxt.N + nxt.n0 + (lane & 31)]; }
#pragma unroll
            for (int i = 0; i < 32; ++i) { const int kk = 2 * i + (lane >> 5); float w = wv[i]; if (cur.ks) w *= cur.ks[cur.k0 + kk]; scr[kk * 33 + (lane & 31)] = w; }
            LDS_WAIT(); asm volatile("" ::: "memory");
            { const int c = lane & 7;
#pragma unroll
              for (int j = 0; j < 4; ++j) { const int n = (lane >> 3) + 8 * j; const LAS float* sp = scr + (8 * c) * 33 + n;
                v4u o; o.x = pk2(sp[0 * 33], sp[1 * 33]); o.y = pk2(sp[2 * 33], sp[3 * 33]); o.z = pk2(sp[4 * 33], sp[5 * 33]); o.w = pk2(sp[6 * 33], sp[7 * 33]);
                *(v4u*)(cur.WT + (size_t)(cur.no + n) * cur.K + cur.k0 + 8 * c) = o; } }
            LDS_WAIT(); asm volatile("" ::: "memory");
            if (hn) {
#pragma unroll
                for (int i = 0; i < 32; ++i) wv[i] = wn[i]; }
            cur = nxt; it = itn;
        }
        for (int e = bx * NTHR + tid; e < 8 * 256 * 128; e += G * NTHR) { const int i = e & 127, jj = (e >> 7) & 127, g = (e >> 14) & 1, n = e >> 15;
            WG[e] = (bf16)f2bf((g ? args.in[7] : args.in[5])[(size_t)n * 16384 + i * 128 + jj]); }
        for (int e = bx * NTHR + tid; e < M; e += G * NTHR) { SS[e] = 0.f; SS2[e] = 0.f; }
        const float* g1 = args.in[1];
        f32x4 gv[4];
#pragma unroll
        for (int q = 0; q < 4; ++q) gv[q] = *((const f32x4*)g1 + lane + 64 * q);
        {
            f32x4 v[4], v2[4], nv[4], nv2[4];
            int m = gw;
            if (m < M) { const f32x4* xr = (const f32x4*)(x + (size_t)m * DM) + lane; const f32x4* xr2 = (const f32x4*)(x + (size_t)((m + NGW < M) ? m + NGW : m) * DM) + lane;
#pragma unroll
                for (int q = 0; q < 4; ++q) { v[q] = xr[64 * q]; v2[q] = xr2[64 * q]; } }
            while (m < M) {
                const int m2 = m + NGW; const bool has2 = m2 < M; const int mn = m + 2 * NGW; const bool hn = mn < M;
                if (hn) { const f32x4* xr = (const f32x4*)(x + (size_t)mn * DM) + lane; const f32x4* xr2 = (const f32x4*)(x + (size_t)((mn + NGW < M) ? mn + NGW : mn) * DM) + lane;
#pragma unroll
                    for (int q = 0; q < 4; ++q) { nv[q] = xr[64 * q]; nv2[q] = xr2[64 * q]; } }
                float s = 0.f, s2 = 0.f;
#pragma unroll
                for (int q = 0; q < 4; ++q) { s += (v[q].x * v[q].x + v[q].y * v[q].y) + (v[q].z * v[q].z + v[q].w * v[q].w); s2 += (v2[q].x * v2[q].x + v2[q].y * v2[q].y) + (v2[q].z * v2[q].z + v2[q].w * v2[q].w); }
                const float rs = __builtin_amdgcn_rsqf(wave_sum(s) * (1.f / DM) + EPS), rs2 = __builtin_amdgcn_rsqf(wave_sum(s2) * (1.f / DM) + EPS);
                unsigned long long* o8 = (unsigned long long*)(XN + (size_t)m * DM) + lane;
#pragma unroll
                for (int q = 0; q < 4; ++q) o8[64 * q] = (unsigned long long)pk2(v[q].x * rs * gv[q].x, v[q].y * rs * gv[q].y) | ((unsigned long long)pk2(v[q].z * rs * gv[q].z, v[q].w * rs * gv[q].w) << 32);
                if (has2) { unsigned long long* p8 = (unsigned long long*)(XN + (size_t)m2 * DM) + lane;
#pragma unroll
                    for (int q = 0; q < 4; ++q) p8[64 * q] = (unsigned long long)pk2(v2[q].x * rs2 * gv[q].x, v2[q].y * rs2 * gv[q].y) | ((unsigned long long)pk2(v2[q].z * rs2 * gv[q].z, v2[q].w * rs2 * gv[q].w) << 32); }
                if (hn) {
#pragma unroll
                    for (int q = 0; q < 4; ++q) { v[q] = nv[q]; v2[q] = nv2[q]; } }
                m = mn;
            }
        }
    }
    xcd_barrier(xbar);
    if (G == 0x7fffffff) grid.sync();
    {
        pg8::Gemm g{XN, WinT, M, DIN, DM}; pg8::StaticOrder S; S.init(M, DIN, G, bx);
        pg8::Epi<0> E{S0, nullptr, nullptr, nullptr, nullptr, DM, DM, (size_t)SLOT / 2, 2, attn_body::C2};
        pg8::gemm_phase<pg8::Epi<0>, pg8::StaticOrder, true, true>(L, g, S, E);
    }
    xcd_barrier(xbar);
    {
        const attn_body::AttnTensors AT{(const attn_body::bf16*)Qb, (const attn_body::bf16*)Kb, (const attn_body::bf16*)Vb, (attn_body::bf16*)YATT, args.in[10], args.in[11], args.in[12], args.in[13], args.in[14]};
        const attn_body::StaticOrder S(G, bx);
        attn_body::attn_phase<attn_body::StaticOrder>((char*)lds, AT, S);
        __syncthreads();
        for (int u = vcu; u < 512; u += G) rnn_unit<0>(L, u >> 2, u & 3, XR, GRb, YRNN, WG, SUMM, args.in[3], args.in[4], args.in[6], args.in[8], args.in[9]);
    }
    xcd_barrier(xbar);
    {
        PHASE_IDS();
        for (int u = vcu; u < 512; u += G) rnn_unit<1>(L, u >> 2, u & 3, XR, GRb, YRNN, WG, SUMM, args.in[3], args.in[4], args.in[6], args.in[8], args.in[9]);
    }
    xcd_barrier(xbar);
    {
        pg8::StaticOrder S; S.init(M, DM, G, bx);
        pg8::Gemm g{YRNN, PAT, M, DM, DM, YATT, PBT}; pg8::EpiMerge E{MERGED, GRNN, GATT};
        pg8::gemm_phase<pg8::EpiMerge, pg8::StaticOrder, true, true, true>(L, g, S, E);
    }
    xcd_barrier(xbar);
    {
        pg8::Gemm g{MERGED, WoT, M, DM, DM}; pg8::StaticOrder S; S.init(M, DM, G, bx);
        pg8::EpiRes3 E{X1B, x, SS};
        pg8::gemm_phase<pg8::EpiRes3, pg8::StaticOrder, true, true>(L, g, S, E);
    }
    xcd_barrier(xbar);
    {
        pg8::Gemm g{X1B, WupT, M, 2 * DFF, DM}; pg8::StaticOrder S; S.init(M, 2 * DFF, G, bx);
        pg8::EpiAct E{ACT, SS, args.in[20], args.in[21], SG, SV};
        pg8::gemm_phase<pg8::EpiAct, pg8::StaticOrder, true, true>(L, g, S, E);
    }
    xcd_barrier(xbar);
    {
        PHASE_IDS();
        const float* cw = args.in[20]; const float* cb = args.in[21];
        for (int it = bx * NTHR + tid; it < (M / 64) * 384; it += G * NTHR) {
            const int chunk = it % 384, strip = it / 384, cc = chunk * 8;
            const bool first = (strip % (SEQ / 64)) == 0;
            v4u p2 = (v4u){0u, 0u, 0u, 0u}, p1 = p2;
            if (!first) { p2 = *(const v4u*)(SG + ((size_t)(strip - 1) * 4 + 0) * DFF + cc); p1 = *(const v4u*)(SG + ((size_t)(strip - 1) * 4 + 1) * DFF + cc); }
            const v4u g0 = *(const v4u*)(SG + ((size_t)strip * 4 + 2) * DFF + cc), g1 = *(const v4u*)(SG + ((size_t)strip * 4 + 3) * DFF + cc);
            const v4u v0 = *(const v4u*)(SV + ((size_t)strip * 2 + 0) * DFF + cc), v1 = *(const v4u*)(SV + ((size_t)strip * 2 + 1) * DFF + cc);
            const unsigned P2[4] = {p2.x, p2.y, p2.z, p2.w}, P1[4] = {p1.x, p1.y, p1.z, p1.w}, G0[4] = {g0.x, g0.y, g0.z, g0.w}, G1[4] = {g1.x, g1.y, g1.z, g1.w}, V0[4] = {v0.x, v0.y, v0.z, v0.w}, V1[4] = {v1.x, v1.y, v1.z, v1.w};
            unsigned o0[4], o1[4];
#pragma unroll
            for (int q = 0; q < 4; ++q) {
                float r0[2], r1[2];
#pragma unroll
                for (int hh = 0; hh < 2; ++hh) { const int c = cc + 2 * q + hh;
                    const float w0 = cw[c], w1 = cw[DFF + c], w2 = cw[2 * DFF + c], b = cb[c];
                    const float a2 = hh ? bfhi(P2[q]) : bflo(P2[q]), a1 = hh ? bfhi(P1[q]) : bflo(P1[q]), x0 = hh ? bfhi(G0[q]) : bflo(G0[q]), x1 = hh ? bfhi(G1[q]) : bflo(G1[q]);
                    const float u0 = hh ? bfhi(V0[q]) : bflo(V0[q]), u1 = hh ? bfhi(V1[q]) : bflo(V1[q]);
                    r0[hh] = gelu_tanh(b + w0 * a2 + w1 * a1 + w2 * x0) * u0;
                    r1[hh] = gelu_tanh(b + w0 * a1 + w1 * x0 + w2 * x1) * u1; }
                o0[q] = pk2(r0[0], r0[1]); o1[q] = pk2(r1[0], r1[1]); }
            *(v4u*)(ACT + ((size_t)strip * 64 + 0) * DFF + cc) = (v4u){o0[0], o0[1], o0[2], o0[3]};
            *(v4u*)(ACT + ((size_t)strip * 64 + 1) * DFF + cc) = (v4u){o1[0], o1[1], o1[2], o1[3]};
        }
    }
    xcd_barrier(xbar);
    const bool fuse9 = (G == 256);
    if (fuse9) {
        pg8::Gemm g{ACT, WdnT, M, DM, DFF}; pg8::StaticOrder S; S.init(M, DM, G, bx);
        pg8::EpiRes5F E{out, X1B, SS2, args.in[23], (unsigned*)(ws + WS_PCNT)};
        pg8::gemm_phase<pg8::EpiRes5F, pg8::StaticOrder, true, true>(L, g, S, E);
    } else {
        pg8::Gemm g{ACT, WdnT, M, DM, DFF}; pg8::StaticOrder S; S.init(M, DM, G, bx);
        pg8::EpiRes5 E{X2B, X1B, SS2};
        pg8::gemm_phase<pg8::EpiRes5, pg8::StaticOrder, true, true>(L, g, S, E);
    }
    if (!fuse9) xcd_barrier(xbar);
    if (!fuse9) {
        PHASE_IDS();
        const float* gf = args.in[23];
        f32x4 gv[2][2];
#pragma unroll
        for (int q = 0; q < 2; ++q) { gv[q][0] = *(const f32x4*)(gf + q * 512 + lane * 8); gv[q][1] = *(const f32x4*)(gf + q * 512 + lane * 8 + 4); }
        {
            v4u xv[4][2], nx[4][2]; float ssv[4], nss[4];
            int m0 = gw * 4;
            if (m0 < M) {
#pragma unroll
                for (int k = 0; k < 4; ++k) { const bf16* xr = X2B + (size_t)(m0 + k) * DM + lane * 8; xv[k][0] = *(const v4u*)xr; xv[k][1] = *(const v4u*)(xr + 512); ssv[k] = SS2[m0 + k]; } }
            while (m0 < M) {
                const int mn = m0 + NGW * 4; const bool hn = mn < M;
                if (hn) {
#pragma unroll
                    for (int k = 0; k < 4; ++k) { const bf16* xr = X2B + (size_t)(mn + k) * DM + lane * 8; nx[k][0] = *(const v4u*)xr; nx[k][1] = *(const v4u*)(xr + 512); nss[k] = SS2[mn + k]; } }
#pragma unroll
                for (int k = 0; k < 4; ++k) { float* orow = out + (size_t)(m0 + k) * DM + lane * 8; const float rs = __builtin_amdgcn_rsqf(ssv[k] * (1.f / DM) + EPS);
#pragma unroll
                    for (int q = 0; q < 2; ++q) { const v4u w = xv[k][q];
                        f32x4 a = (f32x4){bflo(w.x), bfhi(w.x), bflo(w.y), bfhi(w.y)}, b = (f32x4){bflo(w.z), bfhi(w.z), bflo(w.w), bfhi(w.w)};
                        *(f32x4*)(orow + q * 512) = a * rs * gv[q][0]; *(f32x4*)(orow + q * 512 + 4) = b * rs * gv[q][1]; } }
                if (hn) {
#pragma unroll
                    for (int k = 0; k < 4; ++k) { xv[k][0] = nx[k][0]; xv[k][1] = nx[k][1]; ssv[k] = nss[k]; } }
                m0 = mn;
            }
        }
    }
}

extern "C" void kernel_launch(void* const* d_in, const int* in_sizes, int n_in, void* d_out, int out_size, void* d_ws, size_t ws_size, hipStream_t stream) {
    static int grid = 0;
    if (grid == 0) {
        if (n_in != 24 || in_sizes[0] != M * DM || out_size != M * DM || ws_size < WS_NEED) { fprintf(stderr, "kernel_launch: unexpected shapes / workspace (n_in %d, in0 %d, out %d, ws %zu, need %zu)\n", n_in, n_in > 0 ? in_sizes[0] : -1, out_size, ws_size, (size_t)WS_NEED); grid = -1; return; }
        int dev = 0, cus = 0, per_cu = 0;
        hipGetDevice(&dev); hipDeviceGetAttribute(&cus, hipDeviceAttributeMultiprocessorCount, dev);
        if (hipFuncSetAttribute((const void*)fwd_megakernel, hipFuncAttributeMaxDynamicSharedMemorySize, LDS_BYTES) != hipSuccess) { fprintf(stderr, "kernel_launch: hipFuncSetAttribute failed\n"); grid = -1; return; }
        if (hipOccupancyMaxActiveBlocksPerMultiprocessor(&per_cu, (const void*)fwd_megakernel, NTHR, LDS_BYTES) != hipSuccess || per_cu < 1) { fprintf(stderr, "kernel_launch: occupancy query gave %d\n", per_cu); per_cu = 1; (void)hipGetLastError(); }
        grid = cus * 1;
        if (per_cu < 1) grid = -1;
    }
    if (grid < 0) return;
    Args a{};
    for (int i = 0; i < 24; ++i) a.in[i] = (const float*)d_in[i];
    a.out = (float*)d_out; a.ws = (unsigned char*)d_ws;
    if (hipMemsetAsync((char*)d_ws + WS_BAR, 0, WS_ZERO_BYTES, stream) != hipSuccess) { fprintf(stderr, "kernel_launch: memset of the barrier words failed\n"); return; }
    void* kargs[] = {&a};
    hipError_t e = hipLaunchCooperativeKernel((const void*)fwd_megakernel, dim3(grid), dim3(NTHR), kargs, LDS_BYTES, stream);
    if (e != hipSuccess) fprintf(stderr, "cooperative launch failed: %s (grid %d)\n", hipGetErrorString(e), grid);
}
```
